# Optimizing an MI355X kernel written in HIP

```python
import math
import jax, jax.numpy as jnp
from jax import lax
import numpy as np

D_MODEL = 1024
BATCH = 8
SEQ = 2048
DEPTH = 4

CHUNK = 64
N_META = 16
N_A_LAYERS = DEPTH // 2
N_B_LAYERS = DEPTH - N_A_LAYERS
D_RNN = 3 * D_MODEL // 2
N_LRU_BLOCKS = 16
LRU_BLOCK = D_RNN // N_LRU_BLOCKS
LRU_C = 8.0
CONV_A_WIDTH = 4
N_FOX_HEADS = 16
FOX_HEAD_DIM = D_MODEL // N_FOX_HEADS
Q_BLOCK = 128
D_FF = ((8 * D_MODEL // 3 + 255) // 256) * 256
CONV_F_WIDTH = 3
DN_ALPHA = (2 * DEPTH) ** 0.25
DN_BETA = (8 * DEPTH) ** -0.25
LN_EPS = 1e-5

kernel_name = "yoco_rglru_fox_convffn_deepnorm"


def layer_norm(x, g, b):
    xf = x.astype(jnp.float32)
    mu = jnp.mean(xf, axis=-1, keepdims=True)
    var = jnp.mean(jnp.square(xf - mu), axis=-1, keepdims=True)
    y = (xf - mu) * lax.rsqrt(var + LN_EPS)
    return (y * g.astype(jnp.float32) + b.astype(jnp.float32)).astype(x.dtype)


def causal_dwconv(x, w, b):
    width = w.shape[0]
    length = x.shape[1]
    xp = jnp.pad(x, ((0, 0), (width - 1, 0), (0, 0)))
    y = b
    for k in range(width):
        y = y + xp[:, k:k + length] * w[k]
    return y


def rg_lru(x, w_r, b_r, w_i, b_i, lam):
    bsz, length, width = x.shape
    xb = x.reshape(bsz, length, N_LRU_BLOCKS, LRU_BLOCK)
    r = jax.nn.sigmoid(jnp.einsum('blnc,ncd->blnd', xb, w_r).reshape(bsz, length, width) + b_r)
    i = jax.nn.sigmoid(jnp.einsum('blnc,ncd->blnd', xb, w_i).reshape(bsz, length, width) + b_i)
    log_a = -LRU_C * r.astype(jnp.float32) * jax.nn.softplus(-lam.astype(jnp.float32))
    a = jnp.exp(log_a)
    u = jnp.sqrt(-jnp.expm1(2.0 * log_a)) * (i * x).astype(jnp.float32)

    def combine(left, right):
        a1, b1 = left
        a2, b2 = right
        return a1 * a2, a2 * b1 + b2

    _, h = lax.associative_scan(combine, (a, u), axis=1)
    return h.astype(x.dtype)


def recurrent_mixer(x, w_in, conv_w, conv_b, w_r, b_r, w_i, b_i, lam, w_out):
    gr = x @ w_in
    gate, rec = gr[..., :D_RNN], gr[..., D_RNN:]
    rec = causal_dwconv(rec, conv_w, conv_b)
    h = rg_lru(rec, w_r, b_r, w_i, b_i, lam)
    return (jax.nn.gelu(gate) * h) @ w_out


def conv_ffn(x, w_in, conv_w, conv_b, w_out):
    h = causal_dwconv(x @ w_in, conv_w, conv_b)
    gate, val = h[..., :D_FF], h[..., D_FF:]
    return (jax.nn.gelu(gate) * val) @ w_out


def to_heads_padded(t, lp):
    bsz, length, _ = t.shape
    t = t.reshape(bsz, length, N_FOX_HEADS, FOX_HEAD_DIM).transpose(0, 2, 1, 3)
    return jnp.pad(t, ((0, 0), (0, 0), (0, lp - length), (0, 0)))


def shared_kv(x, kv_w, f_b):
    length = x.shape[1]
    lp = -(-length // Q_BLOCK) * Q_BLOCK
    z = x @ kv_w
    k = to_heads_padded(z[..., :D_MODEL], lp)
    v = to_heads_padded(z[..., D_MODEL:2 * D_MODEL], lp)
    log_f = jax.nn.log_sigmoid(z[..., 2 * D_MODEL:].astype(jnp.float32) + f_b.astype(jnp.float32))
    c = jnp.cumsum(log_f, axis=1).transpose(0, 2, 1)
    c = jnp.pad(c, ((0, 0), (0, 0), (0, lp - length)), mode='edge')
    return k, v, c


def forgetting_attention(q, k, v, c):
    lp = q.shape[2]
    scale = q.shape[-1] ** -0.5
    outs = []
    for q0 in range(0, lp, Q_BLOCK):
        end = q0 + Q_BLOCK
        s = jnp.einsum('bhqd,bhkd->bhqk', q[:, :, q0:end], k[:, :, :end]).astype(jnp.float32) * scale
        s = s + c[:, :, q0:end, None] - c[:, :, None, :end]
        mask = jnp.arange(end)[None, :] <= jnp.arange(q0, end)[:, None]
        s = jnp.where(mask, s, -jnp.inf)
        p = jax.nn.softmax(s, axis=-1).astype(v.dtype)
        outs.append(jnp.einsum('bhqk,bhkd->bhqd', p, v[:, :, :end]))
    return jnp.concatenate(outs, axis=2)


def fox_mixer(x, w_in, w_out, k, v, c):
    bsz, length, _ = x.shape
    qg = x @ w_in
    q = to_heads_padded(qg[..., :D_MODEL], k.shape[2])
    o = forgetting_attention(q, k, v, c)[:, :, :length]
    o = o.transpose(0, 2, 1, 3).reshape(bsz, length, D_MODEL)
    return (o * jax.nn.sigmoid(qg[..., D_MODEL:])) @ w_out


def setup_inputs(seed: int = 0) -> dict:
    key = jax.random.key(seed)
    ks = jax.random.split(key, 24)
    f32 = jnp.float32
    d = D_MODEL

    def nrm(k, shape, scale):
        return jax.random.normal(k, shape, f32) * scale

    u = jax.random.uniform(ks[9], (N_A_LAYERS, D_RNN), f32, 0.9, 0.999)
    a0 = u ** (1.0 / LRU_C)
    lam = jnp.log(a0) - jnp.log1p(-a0)

    kv_w = jnp.concatenate([
        nrm(ks[11], (d, d), d ** -0.5),
        nrm(ks[12], (d, d), d ** -0.5 * DN_BETA),
        nrm(ks[13], (d, N_FOX_HEADS), d ** -0.5),
    ], axis=1)

    return {
        "x": nrm(ks[0], (BATCH, SEQ, d), 1.0),
        "meta": nrm(ks[1], (N_META, d), 1.0),
        "a_w_in": nrm(ks[2], (N_A_LAYERS, d, 2 * D_RNN), d ** -0.5),
        "a_conv_w": nrm(ks[3], (N_A_LAYERS, CONV_A_WIDTH, D_RNN), CONV_A_WIDTH ** -0.5),
        "a_conv_b": nrm(ks[4], (N_A_LAYERS, D_RNN), 0.02),
        "a_w_r": nrm(ks[5], (N_A_LAYERS, N_LRU_BLOCKS, LRU_BLOCK, LRU_BLOCK), LRU_BLOCK ** -0.5),
        "a_b_r": nrm(ks[6], (N_A_LAYERS, D_RNN), 0.02),
        "a_w_i": nrm(ks[7], (N_A_LAYERS, N_LRU_BLOCKS, LRU_BLOCK, LRU_BLOCK), LRU_BLOCK ** -0.5),
        "a_b_i": nrm(ks[8], (N_A_LAYERS, D_RNN), 0.02),
        "a_lambda": lam,
        "a_w_out": nrm(ks[10], (N_A_LAYERS, D_RNN, d), D_RNN ** -0.5 * DN_BETA),
        "kv_w": kv_w,
        "kv_f_b": jax.random.uniform(ks[14], (N_FOX_HEADS,), f32, 1.0, 4.0),
        "b_w_in": nrm(ks[15], (N_B_LAYERS, d, 2 * d), d ** -0.5),
        "b_w_out": nrm(ks[16], (N_B_LAYERS, d, d), d ** -0.5 * DN_BETA),
        "f_w_in": nrm(ks[17], (DEPTH, d, 2 * D_FF), d ** -0.5),
        "f_conv_w": nrm(ks[18], (DEPTH, CONV_F_WIDTH, 2 * D_FF), CONV_F_WIDTH ** -0.5),
        "f_conv_b": nrm(ks[19], (DEPTH, 2 * D_FF), 0.02),
        "f_w_out": nrm(ks[20], (DEPTH, D_FF, d), D_FF ** -0.5 * DN_BETA),
        "ln1_g": 1.0 + nrm(ks[21], (DEPTH, d), 0.02),
        "ln1_b": nrm(ks[22], (DEPTH, d), 0.02),
        "ln2_g": 1.0 + nrm(ks[23], (DEPTH, d), 0.02),
        "ln2_b": nrm(jax.random.fold_in(key, 99), (DEPTH, d), 0.02),
    }


def reference(x, meta, a_w_in, a_conv_w, a_conv_b, a_w_r, a_b_r, a_w_i, a_b_i, a_lambda, a_w_out,
              kv_w, kv_f_b, b_w_in, b_w_out, f_w_in, f_conv_w, f_conv_b, f_w_out,
              ln1_g, ln1_b, ln2_g, ln2_b):
    bsz = x.shape[0]
    h = jnp.concatenate([jnp.broadcast_to(meta.astype(x.dtype), (bsz, N_META, D_MODEL)), x], axis=1)
    k = v = c = None
    for layer in range(DEPTH):
        if layer < N_A_LAYERS:
            mix = recurrent_mixer(h, a_w_in[layer], a_conv_w[layer], a_conv_b[layer],
                                  a_w_r[layer], a_b_r[layer], a_w_i[layer], a_b_i[layer],
                                  a_lambda[layer], a_w_out[layer])
        else:
            if layer == N_A_LAYERS:
                k, v, c = shared_kv(h, kv_w, kv_f_b)
            j = layer - N_A_LAYERS
            mix = fox_mixer(h, b_w_in[j], b_w_out[j], k, v, c)
        h = layer_norm(DN_ALPHA * h + mix, ln1_g[layer], ln1_b[layer])
        ffn = conv_ffn(h, f_w_in[layer], f_conv_w[layer], f_conv_b[layer], f_w_out[layer])
        h = layer_norm(DN_ALPHA * h + ffn, ln2_g[layer], ln2_b[layer])
    return h[:, N_META:]
```

```cpp
#include <hip/hip_runtime.h>
#include <hip/hip_cooperative_groups.h>
#include <cstdint>
#include <cstdio>
namespace cg = cooperative_groups;

typedef unsigned short bf16_t;
typedef short bf16x8 __attribute__((ext_vector_type(8)));
typedef float f32x4 __attribute__((ext_vector_type(4)));
typedef unsigned u32x4 __attribute__((ext_vector_type(4)));
typedef unsigned u32x2 __attribute__((ext_vector_type(2)));

constexpr int NB = 8, LSEQ = 2064, NMETA = 16, SEQ = 2048, M = NB * LSEQ  , MP = 16640, PADR = 16;
constexpr int D = 1024, DR = 1536, DFF = 2816, NH = 16, HD = 64, NLB = 16, LB = 96;
constexpr int NCH = 43, TCH = 48;
constexpr float ALPHA = 1.6817928305074290f;
constexpr float LN_EPS = 1e-5f;
constexpr float LOG2E = 1.4426950408889634f;

constexpr size_t ROWS = MP + PADR;
constexpr size_t O_HB = 0;
constexpr size_t O_WFOUT = O_HB + ROWS * D * 2;
constexpr size_t O_WRI = O_WFOUT + (size_t)4 * D * DFF * 2;
constexpr size_t O_AGG = O_WRI + (size_t)2 * 2 * NLB * LB * LB * 2;
constexpr size_t O_LOGF = O_AGG + (size_t)2 * NB * NCH * DR * 4;
constexpr size_t O_CT = O_LOGF + (size_t)NB * NH * LSEQ * 4;
constexpr size_t O_HIN = O_CT + (size_t)NB * NH * LSEQ * 4;
constexpr size_t O_END = O_HIN + (size_t)NB * NCH * DR * 4;
static_assert(O_END <= (size_t)NB * SEQ * D * 4, "d_out scratch map");
constexpr size_t W_CTL = 0;
constexpr size_t W_AIN = 4096;
constexpr size_t W_AOUT = W_AIN + (size_t)2 * 3072 * 1024 * 2;
constexpr size_t W_KV = W_AOUT + (size_t)2 * 1024 * 1536 * 2;
constexpr size_t W_BIN = W_KV + (size_t)2048 * 1024 * 2;
constexpr size_t W_BOUT = W_BIN + (size_t)2 * 2048 * 1024 * 2;
constexpr size_t W_FIN = W_BOUT + (size_t)2 * 1024 * 1024 * 2;
constexpr size_t W_HF = W_FIN + (size_t)4 * 5632 * 1024 * 2;
constexpr size_t W_BIG = W_HF + ROWS * D * 4;
constexpr size_t W_YB = W_BIG + ROWS * 3072 * 2;
constexpr size_t W_K = W_YB + ROWS * 1024 * 2;
constexpr size_t W_VT = W_K + ROWS * 1024 * 2;
constexpr size_t W_PART = W_VT + (size_t)NB * NH * HD * LSEQ * 2;
constexpr size_t W_END = W_PART + (size_t)11 * 256 * D * 2;
static_assert(W_END <= (size_t)369098752, "d_ws map must fit 4 x largest input");
static_assert(W_YB + ROWS * DR * 2 <= W_END, "A-layer y fits");

struct Params {
    const float *x, *meta, *a_w_in, *a_conv_w, *a_conv_b, *a_w_r, *a_b_r, *a_w_i, *a_b_i, *a_lambda, *a_w_out, *kv_w, *kv_f_b, *b_w_in, *b_w_out,
        *f_w_in, *f_conv_w, *f_conv_b, *f_w_out, *ln1_g, *ln1_b, *ln2_g, *ln2_b;
    float* out; unsigned char* ws;
    int ph_lo, ph_hi;
};

__device__ __forceinline__ unsigned f2bf(float f) { unsigned u = __builtin_bit_cast(unsigned, f); return (u + 0x7fffu + ((u >> 16) & 1u)) >> 16; }
__device__ __forceinline__ float bf2f(unsigned b) { return __builtin_bit_cast(float, b << 16); }
__device__ __forceinline__ unsigned pk2(float lo, float hi) { return f2bf(lo) | (f2bf(hi) << 16); }
__device__ __forceinline__ float sigmoidf_(float x) { return __builtin_amdgcn_rcpf(1.f + __builtin_amdgcn_exp2f(-LOG2E * x)); }
__device__ __forceinline__ float gelu_tanh(float x) { const float u = 0.7978845608028654f * (x + 0.044715f * x * x * x); return x * __builtin_amdgcn_rcpf(1.f + __builtin_amdgcn_exp2f((-2.f * LOG2E) * u)); }
__device__ __forceinline__ float log1p_pos(float x) { return x < 0.1f ? x * (1.f - x * (0.5f - x * (0.33333333f - x * 0.25f))) : __logf(1.f + x); }
__device__ __forceinline__ float neg_expm1(float y) { return y > -0.25f ? -y * (1.f + y * (0.5f + y * (0.16666667f + y * (0.041666667f + y * 0.0083333333f)))) : 1.f - __expf(y); }
__device__ __forceinline__ float shfl_xor_f(float v, int lane, int o) { return __builtin_bit_cast(float, __builtin_amdgcn_ds_bpermute((lane ^ o) << 2, __builtin_bit_cast(int, v))); }
__device__ __forceinline__ float wave_sum(float v, int lane) {
#pragma unroll
    for (int o = 32; o > 0; o >>= 1) v += shfl_xor_f(v, lane, o);
    return v;
}
__device__ __forceinline__ int opaque_tid() { int t = threadIdx.x; asm volatile("" : "+v"(t)); return t; }

struct Ptrs {
    bf16_t *hb, *wfout, *wri, *ain, *aout, *kv, *bin, *bout, *fin, *big, *yb, *kb, *vt, *part;
    float *agg, *logf, *ct, *hf, *hin; bf16_t* hlo;
};
__device__ __host__ __forceinline__ Ptrs make_ptrs(const Params& p) {
    Ptrs q; unsigned char* o = (unsigned char*)p.out; unsigned char* w = p.ws;
    q.hb = (bf16_t*)(o + O_HB) + (size_t)PADR * D; q.wfout = (bf16_t*)(o + O_WFOUT); q.wri = (bf16_t*)(o + O_WRI);
    q.agg = (float*)(o + O_AGG); q.hin = (float*)(o + O_HIN); q.logf = (float*)(o + O_LOGF); q.ct = (float*)(o + O_CT);
    q.ain = (bf16_t*)(w + W_AIN); q.aout = (bf16_t*)(w + W_AOUT); q.kv = (bf16_t*)(w + W_KV); q.bin = (bf16_t*)(w + W_BIN); q.bout = (bf16_t*)(w + W_BOUT); q.fin = (bf16_t*)(w + W_FIN);
    q.hf = (float*)(w + W_HF) + (size_t)PADR * D; q.hlo = (bf16_t*)(w + W_HF) + (size_t)PADR * D;
    q.big = (bf16_t*)(w + W_BIG);
    q.yb = (bf16_t*)(w + W_YB);
    q.kb = (bf16_t*)(w + W_K) + (size_t)PADR * D; q.vt = (bf16_t*)(w + W_VT); q.part = (bf16_t*)(w + W_PART);
    return q;
}

__device__ __forceinline__ int rowmap(int n, int mode) {
    if (mode == 0) return n;
    const int bj = n / DFF, jj = n % DFF; return (jj >> 7) * 256 + bj * 128 + (jj & 127);
}
__device__ __forceinline__ void transpose_convert(const float* __restrict__ W, int K, int N, int ldw, bf16_t* __restrict__ Wt, int mode, float* slab, int nwaves, int gwave, int lane) {
    const int tn = N / 64, nt = (K / 64) * tn;
    for (int t = gwave; t < nt; t += nwaves) {
        const int k0 = (t / tn) * 64, n0 = (t % tn) * 64;
        f32x4 v[16];
#pragma unroll
        for (int r4 = 0; r4 < 16; ++r4) v[r4] = *(const f32x4*)(W + (size_t)(k0 + r4 * 4 + (lane >> 4)) * ldw + n0 + (lane & 15) * 4);
#pragma unroll
        for (int r4 = 0; r4 < 16; ++r4)
#pragma unroll
            for (int e = 0; e < 4; ++e) slab[((lane & 15) * 4 + e) * 65 + r4 * 4 + (lane >> 4)] = v[r4][e];
#pragma unroll 4
        for (int i = 0; i < 32; ++i) { const int n = i * 2 + (lane >> 5), kp = lane & 31;
            const float a = slab[n * 65 + 2 * kp], c = slab[n * 65 + 2 * kp + 1];
            *(unsigned*)(Wt + (size_t)rowmap(n0 + n, mode) * K + k0 + 2 * kp) = pk2(a, c); }
    }
}
struct WMat { const float* W; bf16_t* Wt; int K, N, ldw, mode; };
__device__ __forceinline__ WMat wmat(const Params& p, const Ptrs& q, int m) {
    WMat r;
    if (m < 2)       { r.W = p.a_w_in + (size_t)m * D * 3072; r.Wt = q.ain + (size_t)m * 3072 * D; r.K = D; r.N = 3072; r.ldw = 3072; r.mode = 0; }
    else if (m < 4)  { const int l = m - 2; r.W = p.a_w_out + (size_t)l * DR * D; r.Wt = q.aout + (size_t)l * D * DR; r.K = DR; r.N = D; r.ldw = D; r.mode = 0; }
    else if (m < 6)  { const int l = m - 4; r.W = p.b_w_in + (size_t)l * D * 2048; r.Wt = q.bin + (size_t)l * 2048 * D; r.K = D; r.N = 2048; r.ldw = 2048; r.mode = 0; }
    else if (m < 8)  { const int l = m - 6; r.W = p.b_w_out + (size_t)l * D * D; r.Wt = q.bout + (size_t)l * D * D; r.K = D; r.N = D; r.ldw = D; r.mode = 0; }
    else if (m == 8) { r.W = p.kv_w; r.Wt = q.kv; r.K = D; r.N = 2048; r.ldw = 2064; r.mode = 0; }
    else if (m < 13) { const int l = m - 9; r.W = p.f_w_in + (size_t)l * D * 5632; r.Wt = q.fin + (size_t)l * 5632 * D; r.K = D; r.N = 5632; r.ldw = 5632; r.mode = 1; }
    else             { const int l = m - 13; r.W = p.f_w_out + (size_t)l * DFF * D; r.Wt = q.wfout + (size_t)l * D * DFF; r.K = DFF; r.N = D; r.ldw = D; r.mode = 0; }
    return r;
}
__device__ __forceinline__ int wmat_tiles(int m) { return m < 2 ? 768 : m < 4 ? 384 : m < 6 ? 512 : m < 8 ? 256 : m == 8 ? 512 : m < 13 ? 1408 : 704; }
__device__ __forceinline__ void prologue(const Params& p, const Ptrs& q, float* tile0) {
    const int gsz = gridDim.x, gid = blockIdx.x; const int tix_ = opaque_tid(), lane_ = tix_ & 63, wpb_ = blockDim.x >> 6;
    float* slab = tile0 + (tix_ >> 6) * (64 * 65);
    { const int nwaves = gsz * wpb_, gwave = gid * wpb_ + (tix_ >> 6), total = 12800;
      f32x4 vn[16]; WMat cn{}; int k0n = 0, n0n = 0;
#define PRO_FETCH(ft) do { int m_ = 0, t_ = (ft); for (; m_ < 16; ++m_) { const int c_ = wmat_tiles(m_); if (t_ < c_) break; t_ -= c_; } cn = wmat(p, q, m_); const int tn_ = cn.N / 64; k0n = (t_ / tn_) * 64; n0n = (t_ % tn_) * 64; \
          _Pragma("unroll") for (int r4 = 0; r4 < 16; ++r4) vn[r4] = *(const f32x4*)(cn.W + (size_t)(k0n + r4 * 4 + (lane_ >> 4)) * cn.ldw + n0n + (lane_ & 15) * 4); } while (0)
      if (gwave < total) PRO_FETCH(gwave);
      for (int ft = gwave; ft < total; ft += nwaves) {
          f32x4 v[16];
#pragma unroll
          for (int r4 = 0; r4 < 16; ++r4) v[r4] = vn[r4];
          const WMat c = cn; const int k0 = k0n, n0 = n0n;
          if (ft + nwaves < total) PRO_FETCH(ft + nwaves);
#pragma unroll
          for (int r4 = 0; r4 < 16; ++r4)
#pragma unroll
              for (int e = 0; e < 4; ++e) slab[((lane_ & 15) * 4 + e) * 65 + r4 * 4 + (lane_ >> 4)] = v[r4][e];
#pragma unroll 4
          for (int i = 0; i < 32; ++i) { const int n = i * 2 + (lane_ >> 5), kp = lane_ & 31;
              const float a = slab[n * 65 + 2 * kp], cc = slab[n * 65 + 2 * kp + 1];
              *(unsigned*)(c.Wt + (size_t)rowmap(n0 + n, c.mode) * c.K + k0 + 2 * kp) = pk2(a, cc); }
      }
#undef PRO_FETCH
    }
    const size_t gt = (size_t)gid * blockDim.x + opaque_tid(), gn = (size_t)gsz * blockDim.x;
    const float* const wr_src = p.a_w_r; const float* const wi_src = p.a_w_i;
    { const size_t nwri = (size_t)2 * 2 * NLB * LB * LB;
      for (size_t i0 = gt; i0 < nwri; i0 += 5 * gn) {
          float wv_[5];
#pragma unroll
          for (int u = 0; u < 5; ++u) { const size_t ii = i0 + (size_t)u * gn; const size_t i = ii < nwri ? ii : nwri - 1;
              const int c = (int)(i % LB), d = (int)((i / LB) % LB); const size_t ln = (i / (LB * LB)) % (2 * NLB); const int gate = (int)(i / ((size_t)2 * NLB * LB * LB));
              const float* src = gate ? wi_src : wr_src;
              wv_[u] = src[(ln * LB + c) * LB + d]; }
#pragma unroll
          for (int u = 0; u < 5; ++u) { const size_t ii = i0 + (size_t)u * gn; if (ii < nwri) q.wri[ii] = (bf16_t)f2bf(wv_[u]); }
      } }
    { const size_t n4 = (size_t)M * (D / 4);
      for (size_t i0 = gt; i0 < n4; i0 += 8 * gn) {
          f32x4 v[8];
#pragma unroll
          for (int u = 0; u < 8; ++u) { const size_t i = i0 + (size_t)u * gn; const size_t ic = i < n4 ? i : n4 - 1;
              const int row = (int)(ic / (D / 4)), c4 = (int)(ic % (D / 4)) * 4, b = row / LSEQ, t = row % LSEQ;
              v[u] = (t < NMETA) ? *(const f32x4*)(p.meta + (size_t)t * D + c4) : *(const f32x4*)(p.x + ((size_t)b * SEQ + (t - NMETA)) * D + c4); }
#pragma unroll
          for (int u = 0; u < 8; ++u) { const size_t i = i0 + (size_t)u * gn;
              if (i < n4) { const int row = (int)(i / (D / 4)), c4 = (int)(i % (D / 4)) * 4;
                  u32x2 w; w.x = pk2(v[u][0], v[u][1]); w.y = pk2(v[u][2], v[u][3]); *(u32x2*)(q.hb + (size_t)row * D + c4) = w;
                  u32x2 wl; wl.x = pk2(v[u][0] - bf2f(w.x & 0xffffu), v[u][1] - bf2f(w.x >> 16)); wl.y = pk2(v[u][2] - bf2f(w.y & 0xffffu), v[u][3] - bf2f(w.y >> 16)); *(u32x2*)(q.hlo + (size_t)row * D + c4) = wl; } }
      }
    }
}

constexpr int TAIL0 = 16384;
__device__ __forceinline__ void ln_phase(const Params& p, const Ptrs& q, const bf16_t* hsrc, bf16_t* hdup, const bf16_t* __restrict__ mix, int R, const float* g, const float* be, int mode) {
    const int tix = opaque_tid(), lane = tix & 63, wpb = blockDim.x >> 6, gw = (tix >> 6) * gridDim.x + blockIdx.x, nw = gridDim.x * wpb;
    u32x2 hhn[4], hln[4]; u32x2 mn[4], m2n[4];
#define LN_LOAD(r) do { _Pragma("unroll") for (int i = 0; i < 4; ++i) { const size_t o_ = (size_t)(r) * D + i * 256 + lane * 4; hhn[i] = *(const u32x2*)(hsrc + o_); hln[i] = *(const u32x2*)(q.hlo + o_); mn[i] = (r) < TAIL0 ? *(const u32x2*)(mix + o_) : *(const u32x2*)(q.part + o_ - (size_t)TAIL0 * D); m2n[i] = (u32x2){0u, 0u}; } } while (0)
    if (gw < M) LN_LOAD(gw);
    for (int row = gw; row < M; row += nw) {
        f32x4 v[4]; float s = 0.f, s2 = 0.f;
#pragma unroll
        for (int i = 0; i < 4; ++i) { const u32x2 mm = mn[i], m2 = m2n[i];
            const f32x4 hcur = (f32x4){bf2f(hhn[i].x & 0xffffu), bf2f(hhn[i].x >> 16), bf2f(hhn[i].y & 0xffffu), bf2f(hhn[i].y >> 16)} + (f32x4){bf2f(hln[i].x & 0xffffu), bf2f(hln[i].x >> 16), bf2f(hln[i].y & 0xffffu), bf2f(hln[i].y >> 16)};
            v[i] = hcur * ALPHA + ((f32x4){bf2f(mm.x & 0xffffu), bf2f(mm.x >> 16), bf2f(mm.y & 0xffffu), bf2f(mm.y >> 16)} + (f32x4){bf2f(m2.x & 0xffffu), bf2f(m2.x >> 16), bf2f(m2.y & 0xffffu), bf2f(m2.y >> 16)});
            s += v[i][0] + v[i][1] + v[i][2] + v[i][3]; s2 += v[i][0] * v[i][0] + v[i][1] * v[i][1] + v[i][2] * v[i][2] + v[i][3] * v[i][3]; }
        if (row >= TAIL0) {
            if (R == 11) {
#pragma unroll
            for (int r = 1; r < 11; ++r)
#pragma unroll
                for (int i = 0; i < 4; ++i) { const u32x2 mm = *(const u32x2*)(q.part + ((size_t)r * 256 + (row - TAIL0)) * D + i * 256 + lane * 4);
                    const f32x4 a = (f32x4){bf2f(mm.x & 0xffffu), bf2f(mm.x >> 16), bf2f(mm.y & 0xffffu), bf2f(mm.y >> 16)}; v[i] = v[i] + a; }
            } else {
#pragma unroll 5
            for (int r = 1; r < R; ++r)
#pragma unroll
                for (int i = 0; i < 4; ++i) { const u32x2 mm = *(const u32x2*)(q.part + ((size_t)r * 256 + (row - TAIL0)) * D + i * 256 + lane * 4);
                    const f32x4 a = (f32x4){bf2f(mm.x & 0xffffu), bf2f(mm.x >> 16), bf2f(mm.y & 0xffffu), bf2f(mm.y >> 16)}; v[i] = v[i] + a; }
            }
            s = 0.f; s2 = 0.f;
#pragma unroll
            for (int i = 0; i < 4; ++i) { s += v[i][0] + v[i][1] + v[i][2] + v[i][3]; s2 += v[i][0] * v[i][0] + v[i][1] * v[i][1] + v[i][2] * v[i][2] + v[i][3] * v[i][3]; }
        }
        if (row + nw < M) LN_LOAD(row + nw);
#pragma unroll
        for (int o = 32; o > 0; o >>= 1) { const float t1 = shfl_xor_f(s, lane, o), t2 = shfl_xor_f(s2, lane, o); s += t1; s2 += t2; }
        const float mu = s * (1.f / D), var = fmaxf(s2 * (1.f / D) - mu * mu, 0.f);
        const float rstd = rsqrtf(var + LN_EPS);
        const int b = row / LSEQ, t = row % LSEQ;
#pragma unroll
        for (int i = 0; i < 4; ++i) {
            const int c = i * 256 + lane * 4;
            const f32x4 gg = *(const f32x4*)(g + c), bb = *(const f32x4*)(be + c);
            v[i] = (v[i] - mu) * rstd * gg + bb;
            if (mode == 2) { if (t >= NMETA) *(f32x4*)(p.out + ((size_t)b * SEQ + (t - NMETA)) * D + c) = v[i]; }
            else { u32x2 w; w.x = pk2(v[i][0], v[i][1]); w.y = pk2(v[i][2], v[i][3]); *(u32x2*)(q.hb + (size_t)row * D + c) = w; if (hdup) *(u32x2*)(hdup + (size_t)row * D + c) = w;
                   u32x2 wl; wl.x = pk2(v[i][0] - bf2f(w.x & 0xffffu), v[i][1] - bf2f(w.x >> 16)); wl.y = pk2(v[i][2] - bf2f(w.y & 0xffffu), v[i][3] - bf2f(w.y >> 16)); *(u32x2*)(q.hlo + (size_t)row * D + c) = wl; }
        }
        if (mode == 1) {
            float acc[NH];
#pragma unroll
            for (int h = 0; h < NH; ++h) acc[h] = 0.f;
#pragma unroll 4
            for (int k = 0; k < 16; ++k) {
                    const int cidx = (k >> 2) * 256 + lane * 4 + (k & 3);
                    const float* wr = p.kv_w + (size_t)cidx * 2064 + 2048;
                    const f32x4 w0 = *(const f32x4*)(wr), w1 = *(const f32x4*)(wr + 4), w2 = *(const f32x4*)(wr + 8), w3 = *(const f32x4*)(wr + 12);
                    const float hv = bf2f(q.hb[(size_t)row * D + cidx]) + bf2f(q.hlo[(size_t)row * D + cidx]);
                    acc[0] += hv * w0[0]; acc[1] += hv * w0[1]; acc[2] += hv * w0[2]; acc[3] += hv * w0[3];
                    acc[4] += hv * w1[0]; acc[5] += hv * w1[1]; acc[6] += hv * w1[2]; acc[7] += hv * w1[3];
                    acc[8] += hv * w2[0]; acc[9] += hv * w2[1]; acc[10] += hv * w2[2]; acc[11] += hv * w2[3];
                    acc[12] += hv * w3[0]; acc[13] += hv * w3[1]; acc[14] += hv * w3[2]; acc[15] += hv * w3[3];
                }
#pragma unroll
            for (int h = 0; h < NH; ++h) {
                const float z = wave_sum(acc[h], lane) + p.kv_f_b[h];
                const float lf = fminf(z, 0.f) - log1p_pos(__expf(-fabsf(z)));
                if (lane == 0) q.logf[((size_t)b * NH + h) * LSEQ + t] = lf;
            }
        }
    }
}
#undef LN_LOAD

template <class Epi>
__device__ __forceinline__ void gemm_simple(const bf16_t* __restrict__ A, int lda, const bf16_t* __restrict__ Bt, int ldb, int Mrows, int N, int K, Epi epi) {
    const int tix = opaque_tid(), lane = tix & 63, fr = lane & 15, fq = lane >> 4;
    const int gw = (blockIdx.x * blockDim.x + tix) >> 6, nw = (gridDim.x * blockDim.x) >> 6;
    const int tn = N / 64, nt = (Mrows / 64) * tn;
    for (int tile = gw; tile < nt; tile += nw) {
        const int row0 = (tile / tn) * 64, col0 = (tile % tn) * 64;
        f32x4 acc[4][4];
#pragma unroll
        for (int i = 0; i < 4; ++i)
#pragma unroll
            for (int j = 0; j < 4; ++j) acc[i][j] = (f32x4){0.f, 0.f, 0.f, 0.f};
        for (int k0 = 0; k0 < K; k0 += 32) {
            bf16x8 a[4], b[4];
#pragma unroll
            for (int i = 0; i < 4; ++i) { a[i] = *(const bf16x8*)(A + (size_t)(row0 + 16 * i + fr) * lda + k0 + 8 * fq); b[i] = *(const bf16x8*)(Bt + (size_t)(col0 + 16 * i + fr) * ldb + k0 + 8 * fq); }
#pragma unroll
            for (int i = 0; i < 4; ++i)
#pragma unroll
                for (int j = 0; j < 4; ++j) acc[i][j] = __builtin_amdgcn_mfma_f32_16x16x32_bf16(a[i], b[j], acc[i][j], 0, 0, 0);
        }
#pragma unroll
        for (int i = 0; i < 4; ++i)
#pragma unroll
            for (int j = 0; j < 4; ++j)
#pragma unroll
                for (int e = 0; e < 4; ++e) epi(row0 + 16 * i + 4 * fq + e, col0 + 16 * j + fr, acc[i][j][e]);
    }
}
struct EStoreBf16 { bf16_t* C; int ldc; int pad; __device__ void operator()(int r, int c, float v) const { C[(size_t)r * ldc + c] = (bf16_t)f2bf(v); } };
struct EResidual { float* hf; __device__ void operator()(int r, int c, float v) const { float* p = hf + (size_t)r * D + c; *p = ALPHA * *p + v; } };
struct EKV { bf16_t* K; bf16_t* Vt; __device__ void operator()(int r, int c, float v) const {
    if (c < D) K[(size_t)r * D + c] = (bf16_t)f2bf(v);
    else if (r < M) { const int cc = c - D, h = cc >> 6, d = cc & 63, b = r / LSEQ, t = r % LSEQ; Vt[(((size_t)b * NH + h) * HD + d) * LSEQ + t] = (bf16_t)f2bf(v); } } };

__device__ __forceinline__ void ffn1_simple(const bf16_t* __restrict__ hb, const bf16_t* __restrict__ Wt  , const float* __restrict__ cw  , const float* __restrict__ cb, bf16_t* __restrict__ g  , float* zs) {
    const int tix = opaque_tid(), lane = tix & 63, fr = lane & 15, fq = lane >> 4, wv = tix >> 6;
    const int gw = (blockIdx.x * blockDim.x + tix) >> 6, nw = (gridDim.x * blockDim.x) >> 6;
    const int ngrp = (M + 61) / 62, ncg = DFF / 32, nt = ngrp * ncg;
    float* z = zs + wv * 64 * 65;
    for (int tile = gw; tile < nt; tile += nw) {
        const int base = (tile / ncg) * 62 - 2, jj0 = (tile % ncg) * 32;
        f32x4 acc[4][4];
#pragma unroll
        for (int i = 0; i < 4; ++i)
#pragma unroll
            for (int j = 0; j < 4; ++j) acc[i][j] = (f32x4){0.f, 0.f, 0.f, 0.f};
        for (int k0 = 0; k0 < D; k0 += 32) {
            bf16x8 a[4], b[4];
#pragma unroll
            for (int i = 0; i < 4; ++i) {
                a[i] = *(const bf16x8*)(hb + (long)(base + 16 * i + fr) * D + k0 + 8 * fq);
                const int jj = jj0 + 16 * (i & 1) + fr, brow = (jj >> 7) * 256 + (i >> 1) * 128 + (jj & 127);
                b[i] = *(const bf16x8*)(Wt + (size_t)brow * D + k0 + 8 * fq);
            }
#pragma unroll
            for (int i = 0; i < 4; ++i)
#pragma unroll
                for (int j = 0; j < 4; ++j) acc[i][j] = __builtin_amdgcn_mfma_f32_16x16x32_bf16(a[i], b[j], acc[i][j], 0, 0, 0);
        }
#pragma unroll
        for (int i = 0; i < 4; ++i)
#pragma unroll
            for (int j = 0; j < 4; ++j)
#pragma unroll
                for (int e = 0; e < 4; ++e) z[(16 * i + 4 * fq + e) * 65 + 16 * j + fr] = acc[i][j][e];
        const int jl = lane & 31, jj = jj0 + jl;
        const float wg0 = cw[jj], wg1 = cw[5632 + jj], wg2 = cw[2 * 5632 + jj], bg = cb[jj];
        const float wv0 = cw[DFF + jj], wv1 = cw[5632 + DFF + jj], wv2 = cw[2 * 5632 + DFF + jj], bv = cb[DFF + jj];
        for (int i = 0; i < 31; ++i) {
            const int s = 2 + 2 * i + (lane >> 5), row = base + s;
            if (row < M) {
                const int t = row % LSEQ;
                const float g2 = (t >= 2) ? z[(s - 2) * 65 + jl] : 0.f, g1 = (t >= 1) ? z[(s - 1) * 65 + jl] : 0.f, g0 = z[s * 65 + jl];
                const float v2 = (t >= 2) ? z[(s - 2) * 65 + 32 + jl] : 0.f, v1 = (t >= 1) ? z[(s - 1) * 65 + 32 + jl] : 0.f, v0 = z[s * 65 + 32 + jl];
                float zg = bg; zg += g2 * wg0; zg += g1 * wg1; zg += g0 * wg2;
                float zv = bv; zv += v2 * wv0; zv += v1 * wv1; zv += v0 * wv2;
                g[(size_t)row * DFF + jj] = (bf16_t)f2bf(gelu_tanh(zg) * zv);
            }
        }
    }
}

__device__ __forceinline__ void rglru_simple(const bf16_t* __restrict__ gr  , const float* __restrict__ conv_w  , const float* __restrict__ conv_b,
                             const float* __restrict__ w_r  , const float* __restrict__ b_r, const float* __restrict__ w_i, const float* __restrict__ b_i,
                             const float* __restrict__ lam, bf16_t* __restrict__ y  , float* xs  ) {
    const int tix = opaque_tid();
    for (int unit = blockIdx.x; unit < NB * NLB; unit += gridDim.x) {
        const int b = unit / NLB, n = unit % NLB, d = tix < LB ? tix : 0, ch = n * LB + d;
        const bool act = tix < LB;
        const float c0 = conv_w[ch], c1 = conv_w[DR + ch], c2 = conv_w[2 * DR + ch], c3 = conv_w[3 * DR + ch], cb = conv_b[ch];
        const float br = b_r[ch], bi = b_i[ch], sp = log1p_pos(__expf(-lam[ch]));
        const float* wr = w_r + (size_t)n * LB * LB + d; const float* wi = w_i + (size_t)n * LB * LB + d;
        float r0 = 0.f, r1 = 0.f, r2 = 0.f, h = 0.f;
        for (int t = 0; t < LSEQ; ++t) {
            const size_t row = (size_t)b * LSEQ + t;
            float x = 0.f;
            if (act) {
                const float raw = bf2f(gr[row * 3072 + DR + ch]);
                x = cb; x += r0 * c0; x += r1 * c1; x += r2 * c2; x += raw * c3;
                r0 = r1; r1 = r2; r2 = raw;
                xs[(t & 1) * LB + d] = x;
            }
            __syncthreads();
            if (act) {
                float pr = 0.f, pi = 0.f;
                for (int c = 0; c < LB; ++c) { const float xc = xs[(t & 1) * LB + c]; pr += xc * wr[c * LB]; pi += xc * wi[c * LB]; }
                const float r = sigmoidf_(pr + br), ig = sigmoidf_(pi + bi);
                const float la = -8.f * r * sp, a = __expf(la), u = sqrtf(neg_expm1(2.f * la)) * (ig * x);
                h = a * h + u;
                const float gate = bf2f(gr[row * 3072 + ch]);
                y[row * DR + ch] = (bf16_t)f2bf(gelu_tanh(gate) * h);
            }
        }
        __syncthreads();
    }
}

__device__ __forceinline__ void cumsum_simple(const float* __restrict__ logf, float* __restrict__ ct) {
    if (blockIdx.x != gridDim.x - 1) return;
    const int i = opaque_tid(); if (i >= NB * NH) return;
    float c = 0.f; for (int t = 0; t < LSEQ; ++t) { c += logf[(size_t)i * LSEQ + t]; ct[(size_t)i * LSEQ + t] = c; }
}

__device__ __forceinline__ void attn_simple(const bf16_t* __restrict__ qg  , const bf16_t* __restrict__ kb, const bf16_t* __restrict__ vt, const float* __restrict__ ct, bf16_t* __restrict__ y  ) {
    for (int idx = blockIdx.x * blockDim.x + opaque_tid(); idx < NB * NH * LSEQ; idx += gridDim.x * blockDim.x) {
        const int tq = idx % LSEQ, bh = idx / LSEQ, b = bh / NH, h = bh % NH;
        const size_t row = (size_t)b * LSEQ + tq;
        float qv[HD], o[HD];
#pragma unroll
        for (int d = 0; d < HD; ++d) { qv[d] = bf2f(qg[row * 2048 + h * HD + d]); o[d] = 0.f; }
        const float cq = ct[(size_t)bh * LSEQ + tq];
        float m = -INFINITY, l = 0.f;
        for (int s = 0; s <= tq; ++s) {
            const bf16_t* kr = kb + ((size_t)b * LSEQ + s) * D + h * HD;
            float dot = 0.f;
#pragma unroll
            for (int d = 0; d < HD; ++d) dot += qv[d] * bf2f(kr[d]);
            const float logit = dot * 0.125f + (cq - ct[(size_t)bh * LSEQ + s]);
            const float mn = fmaxf(m, logit), sc = __expf(m - mn), pp = __expf(logit - mn);
            l = l * sc + pp; m = mn;
#pragma unroll
            for (int d = 0; d < HD; ++d) o[d] = o[d] * sc + pp * bf2f(vt[((size_t)bh * HD + d) * LSEQ + s]);
        }
        const float il = 1.f / l;
#pragma unroll
        for (int d = 0; d < HD; ++d) { const float gt = bf2f(qg[row * 2048 + D + h * HD + d]); y[row * D + h * HD + d] = (bf16_t)f2bf(o[d] * il * sigmoidf_(gt)); }
    }
}

__device__ __forceinline__ void cumsum_wave(const float* __restrict__ logf, float* __restrict__ ct) {
    const int tix = opaque_tid(), lane = tix & 63, wv = tix >> 6;
    const int seq = wv * (int)gridDim.x + ((int)gridDim.x - 1 - (int)blockIdx.x);
    if (seq >= NB * NH) return;
    const float* src = logf + (size_t)seq * LSEQ; float* dst = ct + (size_t)seq * LSEQ;
    const int t0 = lane * 33;
    float v[33];
#pragma unroll
    for (int k = 0; k < 33; ++k) { const int t = t0 + k; v[k] = src[t < LSEQ ? t : LSEQ - 1]; if (t >= LSEQ) v[k] = 0.f; }
#pragma unroll
    for (int k = 1; k < 33; ++k) v[k] += v[k - 1];
    const float total = v[32]; float incl = total;
#pragma unroll
    for (int d = 1; d < 64; d <<= 1) { const float y = __builtin_bit_cast(float, __builtin_amdgcn_ds_bpermute(((lane - d) & 63) << 2, __builtin_bit_cast(int, incl))); const float m = lane >= d ? 1.f : 0.f; incl += y * m; }
    const float excl = incl - total;
#pragma unroll
    for (int k = 0; k < 33; ++k) { const int t = t0 + k; if (t < LSEQ) dst[t] = v[k] + excl; }
}
#define LAS __attribute__((address_space(3)))
namespace pg8 {
constexpr int BM = 256, BK = 64, HALF = 128, HTB = HALF * BK * 2, STAGE_BYTES = 8 * HTB, NXCD = 8, WGM = 8;
__device__ __forceinline__ int lds_byte(int r, int c) { const int st = (r >> 4) * 2 + (c >> 5), rr = r & 15, cc = c & 31, ob = rr * 64 + cc * 2; return st * 1024 + (ob ^ (((ob >> 9) & 1) << 5)); }
__device__ __forceinline__ void stage_rc(int b, int& R, int& C) { const int st = b / 1024, sb = b % 1024, swz = sb ^ (((sb >> 9) & 1) << 5); R = (st >> 1) * 16 + swz / 64; C = (st & 1) * 32 + (swz % 64) / 2; }
__device__ __forceinline__ int perm32(int rho) { const int n = rho >> 4, i = rho & 15; return 8 * (i >> 2) + 4 * n + (i & 3); }

struct Job { const bf16_t* A; const bf16_t* Bt; int nM, nN, id, kpiece; };
struct Unit { const char* A; const char* B; int pm, pn, job, nt; };
template <bool OVL> struct Sched {
    Job j0, j1, j2; int nj, K, G, c, ld;
    __device__ __forceinline__ bool next(int i, Unit& u) const {
        long L = (long)i * G + c;
        const int n0 = j0.nM * j0.nN, n1 = nj > 1 ? j1.nM * j1.nN : 0, n2 = nj > 2 ? j2.nM * j2.nN : 0;
        if (L >= (long)n0 + n1 + n2) return false;
        const int sel = L < n0 ? 0 : (L < n0 + n1 ? 1 : 2);
        if (sel == 1) L -= n0; else if (sel == 2) L -= n0 + n1;
        const bf16_t *A0 = j0.A, *A1 = j1.A, *A2 = j2.A, *B0 = j0.Bt, *B1 = j1.Bt, *B2 = j2.Bt;
        const int M0 = j0.nM, M1 = j1.nM, M2 = j2.nM, N0 = j0.nN, N1 = j1.nN, N2 = j2.nN, I0 = j0.id, I1 = j1.id, I2 = j2.id, P0 = j0.kpiece, P1 = j1.kpiece, P2 = j2.kpiece;
        const bf16_t* jA = sel == 0 ? A0 : (sel == 1 ? A1 : A2); const bf16_t* jB = sel == 0 ? B0 : (sel == 1 ? B1 : B2);
        const int nM = sel == 0 ? M0 : (sel == 1 ? M1 : M2), nN = sel == 0 ? N0 : (sel == 1 ? N1 : N2), nwg = nM * nN;
        u.job = sel == 0 ? I0 : (sel == 1 ? I1 : I2); const int kp = sel == 0 ? P0 : (sel == 1 ? P1 : P2);
        int wgid = (int)L; { const int q = nwg / NXCD, r = nwg % NXCD, xcd = wgid % NXCD, off = wgid / NXCD; wgid = (xcd < r ? xcd * (q + 1) : r * (q + 1) + (xcd - r) * q) + off; }
        const int nig = WGM * nN, gid = wgid / nig, fm = gid * WGM, gsz = (nM - fm) < WGM ? (nM - fm) : WGM;
        u.pm = fm + ((wgid % nig) % gsz); u.pn = (wgid % nig) / gsz;
        u.A = (const char*)jA + (kp ? (long)u.pm * kp * 2 : (OVL ? ((long)u.pm * 252 - 2) : (long)u.pm * 256) * ld * 2);
        u.B = (const char*)jB + (long)u.pn * 256 * ld * 2 + (kp ? (long)u.pm * kp * 2 : 0L);
        u.nt = (kp ? kp : K) / BK;
        return true;
    }
};

template <class Epi, bool OVL>
__device__ __forceinline__ void gemm_phase(LAS unsigned char* lds, const Sched<OVL> S, const Epi E) {
    const int wid = __builtin_amdgcn_readfirstlane(opaque_tid() >> 6), wr = wid >> 2, wc = wid & 3;
    const int K = S.ld;
    unsigned voffA[2], voffB[2]; int aoff, boff;
#define PG8_LANE_SETUP() do { const int tid = opaque_tid(), lane = tid & 63, fr = lane & 15, fq = lane >> 4; \
        _Pragma("unroll") for (int i = 0; i < 2; ++i) { int R, C; stage_rc(tid * 16 + i * 8192, R, C); const int Rb = Epi::PERM ? ((R & ~31) + perm32(R & 31)) : R; const int Ra = OVL ? (R + 62 * (R >> 6)) : R; \
            voffA[i] = (unsigned)(Ra * K + C) * 2u; voffB[i] = (unsigned)(Rb * K + C) * 2u; } \
        aoff = lds_byte(wr * 64 + fr, fq * 8); boff = lds_byte(wc * 32 + fr, fq * 8); } while (0)
    PG8_LANE_SETUP();
    const size_t kstep = (size_t)(BK * 2);
    const size_t hstep = (size_t)HALF * K * 2;
    const size_t hstepA = OVL ? (size_t)64 * K * 2 : hstep;
    const unsigned ldsw = (unsigned)wid * 1024u;
#define PG8_SA(b, h) (((b) * 2 + (h)) * HTB)
#define PG8_SB(b, h) ((4 + (b) * 2 + (h)) * HTB)
#define PG8_STAGE(bufoff, gbase, voff) do { _Pragma("unroll") for (int _i = 0; _i < 2; ++_i) \
        __builtin_amdgcn_global_load_lds((const unsigned*)((const char*)(gbase) + (voff)[_i]), (LAS unsigned*)(lds + (bufoff) + ldsw + _i * 8192), 16, 0, 0); } while (0)
#define PG8_LDA(dst, b, h) do { _Pragma("unroll") for (int m = 0; m < 4; ++m) _Pragma("unroll") for (int k = 0; k < 2; ++k) dst[m][k] = *(const LAS bf16x8*)(lds + PG8_SA(b, h) + aoff + m * 2048 + k * 1024); } while (0)
#define PG8_LDB(dst, b, h) do { _Pragma("unroll") for (int n = 0; n < 2; ++n) _Pragma("unroll") for (int k = 0; k < 2; ++k) dst[n][k] = *(const LAS bf16x8*)(lds + PG8_SB(b, h) + boff + n * 2048 + k * 1024); } while (0)
#define PG8_MMA(ai, bj, At, Bt) do { __builtin_amdgcn_s_setprio(1); _Pragma("unroll") for (int m = 0; m < 4; ++m) _Pragma("unroll") for (int n = 0; n < 2; ++n) _Pragma("unroll") for (int k = 0; k < 2; ++k) \
        acc[ai][bj][m][n] = __builtin_amdgcn_mfma_f32_16x16x32_bf16(Bt[n][k], At[m][k], acc[ai][bj][m][n], 0, 0, 0); __builtin_amdgcn_s_setprio(0); } while (0)
#define PG8_WAIT_V(n) asm volatile("s_waitcnt vmcnt(" #n ")" ::: "memory")
#define PG8_WAIT_L(n) asm volatile("s_waitcnt lgkmcnt(" #n ")" ::: "memory")
#define PG8_BAR __builtin_amdgcn_s_barrier()
#define PG8_SCHED __builtin_amdgcn_sched_barrier(0)
    Unit cur, nxt; int ui = 0;
    if (!S.next(0, cur)) return;
    f32x4 acc[2][2][4][2];
#pragma unroll
    for (int a = 0; a < 2; ++a)
#pragma unroll
        for (int b = 0; b < 2; ++b)
#pragma unroll
            for (int m = 0; m < 4; ++m)
#pragma unroll
                for (int n = 0; n < 2; ++n) acc[a][b][m][n] = (f32x4){0.f, 0.f, 0.f, 0.f};
    bf16x8 At[4][2], B0[2][2], B1[2][2];
    const char* cA = cur.A; const char* cB = cur.B;
    PG8_STAGE(PG8_SB(0, 0), cB, voffB); PG8_STAGE(PG8_SB(0, 1), cB + hstep, voffB); PG8_STAGE(PG8_SA(0, 0), cA, voffA); PG8_STAGE(PG8_SA(0, 1), cA + hstepA, voffA);
    if (wr == 1) PG8_BAR;
    PG8_WAIT_V(2); PG8_BAR;
    PG8_STAGE(PG8_SB(1, 0), cB + kstep, voffB); PG8_STAGE(PG8_SA(1, 0), cA + kstep, voffA); PG8_STAGE(PG8_SB(1, 1), cB + hstep + kstep, voffB);
    PG8_WAIT_V(6); PG8_BAR;
    for (;;) {
        const bool has_next = S.next(ui + 1, nxt);
        const char* nA = has_next ? nxt.A : cA; const char* nB = has_next ? nxt.B : cB;
        const int nt = cur.nt;
        for (int t = 0; t < nt; t += 2) {
            const bool last = (t == nt - 2);
            const char* a1 = cA + (size_t)(t + 1) * kstep;
            const char* a2 = last ? nA : cA + (size_t)(t + 2) * kstep; const char* b2 = last ? nB : cB + (size_t)(t + 2) * kstep;
            const char* a3 = a2 + kstep; const char* b3 = b2 + kstep;
            PG8_LDB(B0, 0, 0); PG8_LDB(B1, 0, 1); PG8_SCHED; PG8_LDA(At, 0, 0); PG8_STAGE(PG8_SA(1, 1), a1 + hstepA, voffA);
            PG8_WAIT_V(8); PG8_WAIT_L(0); PG8_BAR; PG8_MMA(0, 0, At, B0); PG8_MMA(0, 1, At, B1); PG8_BAR; PG8_SCHED;
            PG8_LDA(At, 0, 1); PG8_STAGE(PG8_SB(0, 0), b2, voffB); PG8_STAGE(PG8_SB(0, 1), b2 + hstep, voffB); PG8_STAGE(PG8_SA(0, 0), a2, voffA);
            PG8_WAIT_V(8); PG8_WAIT_L(0); PG8_BAR; PG8_MMA(1, 0, At, B0); PG8_MMA(1, 1, At, B1); PG8_BAR; PG8_SCHED;
            PG8_LDB(B0, 1, 0); PG8_LDB(B1, 1, 1); PG8_SCHED; PG8_LDA(At, 1, 0); PG8_STAGE(PG8_SA(0, 1), a2 + hstepA, voffA);
            PG8_WAIT_V(8); PG8_WAIT_L(0); PG8_BAR; PG8_MMA(0, 0, At, B0); PG8_MMA(0, 1, At, B1); PG8_BAR; PG8_SCHED;
            PG8_LDA(At, 1, 1); PG8_STAGE(PG8_SB(1, 0), b3, voffB); PG8_STAGE(PG8_SB(1, 1), b3 + hstep, voffB); PG8_STAGE(PG8_SA(1, 0), a3, voffA);
            PG8_WAIT_V(8); PG8_WAIT_L(0); PG8_BAR; PG8_MMA(1, 0, At, B0); PG8_MMA(1, 1, At, B1); PG8_BAR; PG8_SCHED;
        }
        if (wr == 0) PG8_BAR;
        E(acc, cur, wr, wc);
        if (!has_next) break;
#pragma unroll
        for (int a = 0; a < 2; ++a)
#pragma unroll
            for (int b = 0; b < 2; ++b)
#pragma unroll
                for (int m = 0; m < 4; ++m)
#pragma unroll
                    for (int n = 0; n < 2; ++n) acc[a][b][m][n] = (f32x4){0.f, 0.f, 0.f, 0.f};
        cur = nxt; cA = nA; cB = nB; ++ui;
        PG8_LANE_SETUP();
        if (wr == 1) PG8_BAR;
    }
    PG8_WAIT_V(0);
    PG8_BAR;
#undef PG8_LANE_SETUP
#undef PG8_SA
#undef PG8_SB
#undef PG8_STAGE
#undef PG8_LDA
#undef PG8_LDB
#undef PG8_MMA
#undef PG8_WAIT_V
#undef PG8_WAIT_L
#undef PG8_BAR
#undef PG8_SCHED
}

__device__ __forceinline__ unsigned cvt_pk_bf16(float lo, float hi) { unsigned r; asm volatile("v_cvt_pk_bf16_f32 %0, %1, %2" : "=v"(r) : "v"(lo), "v"(hi)); return r; }
__device__ __forceinline__ u32x4 pack8(const f32x4& v0, const f32x4& v1) { u32x4 w; w.x = cvt_pk_bf16(v0[0], v0[1]); w.y = cvt_pk_bf16(v0[2], v0[3]); w.z = cvt_pk_bf16(v1[0], v1[1]); w.w = cvt_pk_bf16(v1[2], v1[3]); return w; }

struct EpiStore { static constexpr bool PERM = true;
    bf16_t* O0; bf16_t* Vt; bf16_t* O2; int ld0, ld2; float qs = 1.f;
    __device__ __forceinline__ void operator()(f32x4 (&acc)[2][2][4][2], const Unit& u, int wr, int wc) const {
        const int lane_ = opaque_tid() & 63, fr = lane_ & 15, fq = lane_ >> 4;
        const int row0 = u.pm * BM + wr * 64 + fr, col0 = u.pn * BM + wc * 32 + 8 * fq;
        if (u.job == 1) {
#pragma unroll
            for (int bj = 0; bj < 2; ++bj) { const int tok = col0 + bj * HALF; if (tok < M) { const int b = tok / LSEQ, t = tok % LSEQ;
#pragma unroll
                for (int ai = 0; ai < 2; ++ai)
#pragma unroll
                    for (int m = 0; m < 4; ++m) { const int f = row0 + ai * HALF + m * 16; *(u32x4*)(Vt + ((size_t)(b * NH + (f >> 6)) * HD + (f & 63)) * LSEQ + t) = pack8(acc[ai][bj][m][0], acc[ai][bj][m][1]); } } }
        } else {
            bf16_t* O = u.job == 0 ? O0 : O2; const int ldc = u.job == 0 ? ld0 : ld2;
            if (u.job == 2 && qs != 1.f && u.pn < 4) {
#pragma unroll
                for (int ai = 0; ai < 2; ++ai)
#pragma unroll
                    for (int m = 0; m < 4; ++m) { bf16_t* rowp = O + (size_t)(row0 + ai * HALF + m * 16) * ldc + col0;
#pragma unroll
                        for (int bj = 0; bj < 2; ++bj) *(u32x4*)(rowp + bj * HALF) = pack8(acc[ai][bj][m][0] * qs, acc[ai][bj][m][1] * qs); }
            } else
#pragma unroll
            for (int ai = 0; ai < 2; ++ai)
#pragma unroll
                for (int m = 0; m < 4; ++m) { bf16_t* rowp = O + (size_t)(row0 + ai * HALF + m * 16) * ldc + col0;
#pragma unroll
                    for (int bj = 0; bj < 2; ++bj) *(u32x4*)(rowp + bj * HALF) = pack8(acc[ai][bj][m][0], acc[ai][bj][m][1]); }
        }
    }
};
struct EpiResidual { static constexpr bool PERM = false;
    float* hf;
    __device__ __forceinline__ void operator()(f32x4 (&acc)[2][2][4][2], const Unit& u, int wr, int wc) const {
        const int lane_ = opaque_tid() & 63, fr = lane_ & 15, fq = lane_ >> 4;
        const int row0 = u.pm * BM + wr * 64 + fr, col0 = u.pn * BM + wc * 32 + 4 * fq;
#pragma unroll
        for (int ai = 0; ai < 2; ++ai)
#pragma unroll
            for (int m = 0; m < 4; ++m) { float* rowp = hf + (size_t)(row0 + ai * HALF + m * 16) * D + col0;
#pragma unroll
                for (int bj = 0; bj < 2; ++bj)
#pragma unroll
                    for (int n = 0; n < 2; ++n) { f32x4* pp = (f32x4*)(rowp + bj * HALF + n * 16); *pp = *pp * ALPHA + acc[ai][bj][m][n]; }
                __builtin_amdgcn_sched_barrier(0); }
    }
};
template <int CTRL> __device__ __forceinline__ float dpp_old(float old, float x) { return __builtin_bit_cast(float, __builtin_amdgcn_update_dpp(__builtin_bit_cast(int, old), __builtin_bit_cast(int, x), CTRL, 0xf, 0xf, false)); }
template <int CTRL> __device__ __forceinline__ float dppf(float x) { return __builtin_bit_cast(float, __builtin_amdgcn_update_dpp(0, __builtin_bit_cast(int, x), CTRL, 0xf, 0xf, true)); }
struct EpiFfn1 { static constexpr bool PERM = true;
    bf16_t* g; const float* cw; const float* cb; LAS float* cwl;
    __device__ __forceinline__ void operator()(f32x4 (&acc)[2][2][4][2], const Unit& u, int wr, int wc) const {
        const int lane_ = opaque_tid() & 63, fr = lane_ & 15, fq = lane_ >> 4;
        const int G0 = u.pm * 252 + wr * 126 - 2, jj0 = u.pn * 128 + wc * 32 + 8 * fq;
        { const int tid = opaque_tid();
#pragma unroll
          for (int i = 0; i < 2; ++i) { const int idx = tid + 512 * i, k = idx >> 8, c = idx & 255, ch = (c >> 7) * DFF + u.pn * 128 + (c & 127);
              cwl[idx] = k < 3 ? cw[k * 5632 + ch] : cb[ch]; }
          asm volatile("s_waitcnt lgkmcnt(0)" ::: "memory"); __builtin_amdgcn_s_barrier(); asm volatile("" ::: "memory"); }
        const int cl0 = wc * 32 + 8 * fq;
#pragma unroll
        for (int blk = 0; blk < 8; ++blk) {
            const int ai = blk >> 2, m = blk & 3, off = 64 * ai + 16 * m + fr, row = G0 + off; const unsigned t = (unsigned)(row + LSEQ) % (unsigned)LSEQ;
            const float tm1 = t >= 1u ? 1.f : 0.f, tm2 = t >= 2u ? 1.f : 0.f;
            f32x4 o[2];
#pragma unroll
            for (int n = 0; n < 2; ++n) {
                f32x4 cv[2];
#pragma unroll
                for (int bj = 0; bj < 2; ++bj) {
                    const int ci = bj * 128 + cl0 + 4 * n;
                    const f32x4 w0 = *(const LAS f32x4*)(cwl + ci), w1 = *(const LAS f32x4*)(cwl + 256 + ci), w2 = *(const LAS f32x4*)(cwl + 512 + ci), bb = *(const LAS f32x4*)(cwl + 768 + ci);
                    const f32x4 cur = acc[ai][bj][m][n]; const f32x4 prev = blk > 0 ? acc[(blk > 0 ? blk - 1 : 0) >> 2][bj][(blk > 0 ? blk - 1 : 0) & 3][n] : (f32x4){0.f, 0.f, 0.f, 0.f};
#pragma unroll
                    for (int e = 0; e < 4; ++e) {
                        const float mp = dppf<0x140>(prev[e]), mps = dppf<0xB1>(mp);
                        const float s1 = dppf<0x111>(cur[e]), s2 = dppf<0x112>(cur[e]);
                        float p1 = fr >= 1 ? s1 : mp, p2 = fr >= 2 ? s2 : mps;
                        p1 = t >= 1u ? p1 : 0.f; p2 = t >= 2u ? p2 : 0.f;
                        float r = bb[e]; r += p2 * w0[e]; r += p1 * w1[e]; r += cur[e] * w2[e]; cv[bj][e] = r;
                    }
                }
#pragma unroll
                for (int e = 0; e < 4; ++e) o[n][e] = gelu_tanh(cv[0][e]) * cv[1][e];
            }
            if (off >= 2 && row < M) *(u32x4*)(g + (size_t)row * DFF + jj0) = pack8(o[0], o[1]);
            __builtin_amdgcn_sched_barrier(0);
        }
    }
};
}
constexpr int SC_WSM = 0, SC_PAR = 2 * LB * 104 * 2  , SC_WAVE = SC_PAR + 3 * LB * 4  , SC_WSTRIDE = 16 * 100 * 4 + 16 * 104 * 2  ;
static_assert(SC_WAVE + 8 * SC_WSTRIDE <= 139264, "scan LDS");
template <int CTRL> __device__ __forceinline__ float dpp_id1(float x) { return __builtin_bit_cast(float, __builtin_amdgcn_update_dpp(0x3f800000, __builtin_bit_cast(int, x), CTRL, 0xf, 0xf, false)); }
template <int PASS>
__device__ __forceinline__ void scan_phase(const Params& p, const Ptrs& q, int layer, unsigned char* smem) {
    const int tix = opaque_tid(), lane = tix & 63, wv = __builtin_amdgcn_readfirstlane(tix >> 6), fr = lane & 15, fq = lane >> 4;
    bf16_t* wsm = (bf16_t*)(smem + SC_WSM); float* par = (float*)(smem + SC_PAR);
    float* xs = (float*)(smem + SC_WAVE + wv * SC_WSTRIDE); bf16_t* xb = (bf16_t*)(smem + SC_WAVE + wv * SC_WSTRIDE + 6400);
    const bf16_t* gr = q.big + (size_t)PADR * 3072; bf16_t* ya = q.yb + (size_t)PADR * DR;
    float* aggA = q.agg; float* aggH = q.agg + (size_t)NB * NCH * DR;
    const float* conv_w = p.a_conv_w + (size_t)layer * 4 * DR; const float* conv_b = p.a_conv_b + (size_t)layer * DR;
    int cur_n = -1;
    for (int bu = blockIdx.x; bu < NLB * NCH; bu += gridDim.x) {
        const int n = bu % NLB, g = bu / NLB;
        const int pidx = 8 * g + wv, b = pidx / NCH, c = pidx % NCH, t0 = TCH * c;
        const bool cl = lane < 48; const int chp = n * LB + 2 * (cl ? lane : 0);
        const bf16_t* rp0 = gr + ((size_t)b * LSEQ + t0) * 3072 + DR + chp;
        unsigned rawn[16];
#pragma unroll
        for (int tt = 0; tt < 16; ++tt) rawn[tt] = *(const unsigned*)(rp0 + (size_t)tt * 3072);
        const unsigned u0 = (t0 >= 3) ? *(const unsigned*)(rp0 - 3 * 3072) : 0u, u1 = (t0 >= 2) ? *(const unsigned*)(rp0 - 2 * 3072) : 0u, u2 = (t0 >= 1) ? *(const unsigned*)(rp0 - 3072) : 0u;
        if (n != cur_n) {
            __syncthreads();
            for (int i = tix; i < 2 * LB * 12; i += 512) { const int gate = i / (LB * 12), rem = i % (LB * 12), d = rem / 12, c8 = rem % 12;
                *(u32x4*)(wsm + (gate * LB + d) * 104 + c8 * 8) = *(const u32x4*)(q.wri + ((((size_t)gate * 2 + layer) * NLB + n) * LB + d) * LB + c8 * 8); }
            if (tix < LB) { const int ch = layer * DR + n * LB + tix; par[tix] = p.a_b_r[ch]; par[LB + tix] = p.a_b_i[ch]; par[2 * LB + tix] = log1p_pos(__expf(-p.a_lambda[ch])); }
            __syncthreads();
            cur_n = n;
        }
        float cw0[2], cw1[2], cw2[2], cw3[2], cbv[2], h0[2], h1[2], h2[2];
#pragma unroll
        for (int e = 0; e < 2; ++e) { cw0[e] = conv_w[chp + e]; cw1[e] = conv_w[DR + chp + e]; cw2[e] = conv_w[2 * DR + chp + e]; cw3[e] = conv_w[3 * DR + chp + e]; cbv[e] = conv_b[chp + e]; }
        h0[0] = bf2f(u0 & 0xffffu); h0[1] = bf2f(u0 >> 16); h1[0] = bf2f(u1 & 0xffffu); h1[1] = bf2f(u1 >> 16); h2[0] = bf2f(u2 & 0xffffu); h2[1] = bf2f(u2 >> 16);
        f32x4 hc[6], Ac[6];
#pragma unroll
        for (int db = 0; db < 6; ++db) { hc[db] = (f32x4){0.f, 0.f, 0.f, 0.f}; Ac[db] = (f32x4){1.f, 1.f, 1.f, 1.f}; }
        if (PASS == 2) {
#pragma unroll
            for (int db = 0; db < 6; ++db) hc[db] = *(const f32x4*)(q.hin + ((size_t)b * NCH + c) * DR + n * LB + 16 * db + 4 * fq);
        }
        for (int s = 0; s < 3; ++s) {
            const size_t rowb = (size_t)b * LSEQ + t0 + 16 * s;
            unsigned raw[16];
#pragma unroll
            for (int tt = 0; tt < 16; ++tt) raw[tt] = rawn[tt];
            if (s < 2) {
#pragma unroll
                for (int tt = 0; tt < 16; ++tt) rawn[tt] = *(const unsigned*)(rp0 + (size_t)(16 * (s + 1) + tt) * 3072);
            }
            u32x2 gg[6];
            if (PASS == 2) {
#pragma unroll
                for (int db = 0; db < 6; ++db) gg[db] = *(const u32x2*)(gr + (rowb + fr) * 3072 + n * LB + 16 * db + 4 * fq);
            }
            if (cl) {
#pragma unroll
                for (int tt = 0; tt < 16; ++tt) {
                    const unsigned uu = raw[tt]; const float r0 = bf2f(uu & 0xffffu), r1 = bf2f(uu >> 16);
                    float x0 = cbv[0]; x0 += h0[0] * cw0[0]; x0 += h1[0] * cw1[0]; x0 += h2[0] * cw2[0]; x0 += r0 * cw3[0];
                    float x1 = cbv[1]; x1 += h0[1] * cw0[1]; x1 += h1[1] * cw1[1]; x1 += h2[1] * cw2[1]; x1 += r1 * cw3[1];
                    h0[0] = h1[0]; h1[0] = h2[0]; h2[0] = r0; h0[1] = h1[1]; h1[1] = h2[1]; h2[1] = r1;
                    xs[tt * 100 + 2 * lane] = x0; xs[tt * 100 + 2 * lane + 1] = x1;
                    *(unsigned*)(xb + tt * 104 + 2 * lane) = pg8::cvt_pk_bf16(x0, x1);
                }
            }
            asm volatile("s_waitcnt lgkmcnt(0)" ::: "memory");
            bf16x8 xf[3];
#pragma unroll
            for (int ks = 0; ks < 3; ++ks) xf[ks] = *(const bf16x8*)(xb + fr * 104 + 32 * ks + 8 * fq);
#pragma unroll
            for (int db = 0; db < 6; ++db) {
                f32x4 pr = (f32x4){0.f, 0.f, 0.f, 0.f}, pi = (f32x4){0.f, 0.f, 0.f, 0.f};
#pragma unroll
                for (int ks = 0; ks < 3; ++ks) {
                    const bf16x8 ar = *(const bf16x8*)(wsm + (16 * db + fr) * 104 + 32 * ks + 8 * fq), ai = *(const bf16x8*)(wsm + (LB + 16 * db + fr) * 104 + 32 * ks + 8 * fq);
                    pr = __builtin_amdgcn_mfma_f32_16x16x32_bf16(ar, xf[ks], pr, 0, 0, 0); pi = __builtin_amdgcn_mfma_f32_16x16x32_bf16(ai, xf[ks], pi, 0, 0, 0);
                }
                const int d0 = 16 * db + 4 * fq;
                const f32x4 br4 = *(const f32x4*)(par + d0), bi4 = *(const f32x4*)(par + LB + d0), sp4 = *(const f32x4*)(par + 2 * LB + d0), x4 = *(const f32x4*)(xs + fr * 100 + d0);
                f32x4 hv;
#pragma unroll
                for (int j = 0; j < 4; ++j) {
                    const float r = sigmoidf_(pr[j] + br4[j]), ig = sigmoidf_(pi[j] + bi4[j]);
                    const float la = -8.f * r * sp4[j];
                    float A = __builtin_amdgcn_exp2f(LOG2E * la), H = __builtin_amdgcn_sqrtf(neg_expm1(2.f * la)) * (ig * x4[j]);
                    { const float Ap = dpp_id1<0x111>(A), Hp = pg8::dppf<0x111>(H); H = A * Hp + H; A = Ap * A; }
                    { const float Ap = dpp_id1<0x112>(A), Hp = pg8::dppf<0x112>(H); H = A * Hp + H; A = Ap * A; }
                    { const float Ap = dpp_id1<0x114>(A), Hp = pg8::dppf<0x114>(H); H = A * Hp + H; A = Ap * A; }
                    { const float Ap = dpp_id1<0x118>(A), Hp = pg8::dppf<0x118>(H); H = A * Hp + H; A = Ap * A; }
                    const float h = A * hc[db][j] + H;
                    hv[j] = h;
                    const int src = ((lane & 48) | 15) << 2;
                    hc[db][j] = __builtin_bit_cast(float, __builtin_amdgcn_ds_bpermute(src, __builtin_bit_cast(int, h)));
                    if (PASS == 1) Ac[db][j] *= __builtin_bit_cast(float, __builtin_amdgcn_ds_bpermute(src, __builtin_bit_cast(int, A)));
                }
                if (PASS == 2) {
                    const size_t row = rowb + fr;
                    const float y0 = gelu_tanh(bf2f(gg[db].x & 0xffffu)) * hv[0], y1 = gelu_tanh(bf2f(gg[db].x >> 16)) * hv[1], y2 = gelu_tanh(bf2f(gg[db].y & 0xffffu)) * hv[2], y3 = gelu_tanh(bf2f(gg[db].y >> 16)) * hv[3];
                    u32x2 w; w.x = pg8::cvt_pk_bf16(y0, y1); w.y = pg8::cvt_pk_bf16(y2, y3);
                    *(u32x2*)(ya + row * DR + n * LB + d0) = w;
                }
            }
        }
        if (PASS == 1 && fr == 0) {
#pragma unroll
            for (int db = 0; db < 6; ++db) { const size_t o = ((size_t)b * NCH + c) * DR + n * LB + 16 * db + 4 * fq; *(f32x4*)(aggA + o) = Ac[db]; *(f32x4*)(aggH + o) = hc[db]; }
        }
    }
}

__device__ __forceinline__ void carry_phase(const Ptrs& q) {
    const int tix_ = opaque_tid(); const int gidx = ((tix_ >> 6) * (int)gridDim.x + (int)blockIdx.x) * 64 + (tix_ & 63);
    if (gidx >= NB * DR) return;
    const int b = gidx / DR, ch = gidx % DR;
    const float* aggA = q.agg + (size_t)b * NCH * DR + ch; const float* aggH = aggA + (size_t)NB * NCH * DR;
    float a[NCH], g[NCH];
#pragma unroll
    for (int cc = 0; cc < NCH; ++cc) { a[cc] = aggA[(size_t)cc * DR]; g[cc] = aggH[(size_t)cc * DR]; }
    float h = 0.f; float* out = q.hin + (size_t)b * NCH * DR + ch;
#pragma unroll
    for (int cc = 0; cc < NCH; ++cc) { out[(size_t)cc * DR] = h; h = a[cc] * h + g[cc]; }
}
constexpr int AT_STRIDE = 72;
constexpr int AT_BUF = 2 * 64 * AT_STRIDE * 2 + 256;
constexpr int AT_MISC = 2 * AT_BUF;
template <bool BAND>
__device__ __forceinline__ void attn_tile(const unsigned char* sb, const bf16x8 (&qf)[2][2], const float (&cq2)[2], float (&mrun)[2], float (&lrun)[2], f32x4 (&o)[2][4],
                                          int i, int j, int wv, int lane, int fr, int fq) {
    const float SC2 = 0.125f * LOG2E;
    const bf16_t* Ks = (const bf16_t*)sb; const bf16_t* Vs = (const bf16_t*)(sb + 64 * AT_STRIDE * 2); const float* Cs = (const float*)(sb + 2 * 64 * AT_STRIDE * 2);
    const bool band = BAND;
    if (!BAND || !(j >= 4 * i && 64 * (j - 4 * i) > 32 * wv + 31)) {
    bf16x8 kf[4][2]; f32x4 cs4[4]; bf16x8 vf[4][2];
#pragma unroll
    for (int kb = 0; kb < 4; ++kb) { kf[kb][0] = *(const bf16x8*)(Ks + (16 * kb + fr) * AT_STRIDE + 8 * fq); kf[kb][1] = *(const bf16x8*)(Ks + (16 * kb + fr) * AT_STRIDE + 32 + 8 * fq); cs4[kb] = *(const f32x4*)(Cs + 16 * kb + 4 * fq); }
    f32x4 s[2][4];
#pragma unroll
    for (int qb = 0; qb < 2; ++qb)
#pragma unroll
        for (int kb = 0; kb < 4; ++kb) {
            f32x4 a = cs4[kb];
            a = __builtin_amdgcn_mfma_f32_16x16x32_bf16(kf[kb][0], qf[qb][0], a, 0, 0, 0);
            a = __builtin_amdgcn_mfma_f32_16x16x32_bf16(kf[kb][1], qf[qb][1], a, 0, 0, 0);
            s[qb][kb] = a;
        }
#pragma unroll
    for (int db = 0; db < 4; ++db)
#pragma unroll
        for (int ks = 0; ks < 2; ++ks) {
            const u32x2 v0 = *(const u32x2*)(Vs + (16 * db + fr) * AT_STRIDE + 32 * ks + 4 * fq), v1 = *(const u32x2*)(Vs + (16 * db + fr) * AT_STRIDE + 32 * ks + 16 + 4 * fq);
            u32x4 w; w.x = v0.x; w.y = v0.y; w.z = v1.x; w.w = v1.y; vf[db][ks] = __builtin_bit_cast(bf16x8, w);
        }
#pragma unroll
    for (int qb = 0; qb < 2; ++qb) {
#pragma unroll
        for (int kb = 0; kb < 4; ++kb) {
            f32x4 a = s[qb][kb];
            if (band) {
                const int pq = 256 * i + 32 * wv + 16 * qb + fr, pk = 64 * j + 16 * kb + 4 * fq;
#pragma unroll
                for (int e = 0; e < 4; ++e) a[e] = (pk + e >= 240 && pk + e <= pq) ? a[e] : -INFINITY;
            }
            s[qb][kb] = a;
        }
        float mx = s[qb][0][0];
#define MX3(a, b, c) __builtin_fmaxf(__builtin_fmaxf((a), (b)), (c))
        mx = MX3(mx, s[qb][0][1], s[qb][0][2]); mx = MX3(mx, s[qb][0][3], s[qb][1][0]); mx = MX3(mx, s[qb][1][1], s[qb][1][2]); mx = MX3(mx, s[qb][1][3], s[qb][2][0]);
        mx = MX3(mx, s[qb][2][1], s[qb][2][2]); mx = MX3(mx, s[qb][2][3], s[qb][3][0]); mx = MX3(mx, s[qb][3][1], s[qb][3][2]); mx = __builtin_fmaxf(mx, s[qb][3][3]);
#undef MX3
        { const auto r16 = __builtin_amdgcn_permlane16_swap(__builtin_bit_cast(unsigned, mx), __builtin_bit_cast(unsigned, mx), false, false);
          mx = __builtin_fmaxf(__builtin_bit_cast(float, r16[0]), __builtin_bit_cast(float, r16[1]));
          const auto r32 = __builtin_amdgcn_permlane32_swap(__builtin_bit_cast(unsigned, mx), __builtin_bit_cast(unsigned, mx), false, false);
          mx = __builtin_fmaxf(__builtin_bit_cast(float, r32[0]), __builtin_bit_cast(float, r32[1])); }
        const float mn = fmaxf(mrun[qb], mx), scl = __builtin_amdgcn_exp2f(mrun[qb] - mn);
        mrun[qb] = mn;
        f32x4 rs4 = (f32x4){0.f, 0.f, 0.f, 0.f};
#pragma unroll
        for (int kb = 0; kb < 4; ++kb) { const f32x4 t = s[qb][kb] - mn; f32x4 pe;
#pragma unroll
            for (int e = 0; e < 4; ++e) pe[e] = __builtin_amdgcn_exp2f(t[e]);
            s[qb][kb] = pe; rs4 = rs4 + pe; }
        const float rs = (rs4[0] + rs4[1]) + (rs4[2] + rs4[3]);
        lrun[qb] = lrun[qb] * scl + rs;
#pragma unroll
        for (int db = 0; db < 4; ++db) o[qb][db] = o[qb][db] * scl;
        bf16x8 pf[2];
#pragma unroll
        for (int ks = 0; ks < 2; ++ks) { const u32x4 w = pg8::pack8(s[qb][2 * ks], s[qb][2 * ks + 1]); pf[ks] = __builtin_bit_cast(bf16x8, w); }
#pragma unroll
        for (int db = 0; db < 4; ++db)
#pragma unroll
            for (int ks = 0; ks < 2; ++ks) o[qb][db] = __builtin_amdgcn_mfma_f32_16x16x32_bf16(vf[db][ks], pf[ks], o[qb][db], 0, 0, 0);
    }
    }
}
__device__ __forceinline__ void attn_phase(const Ptrs& q, const bf16_t* __restrict__ qg, bf16_t* __restrict__ yb, unsigned char* smem, unsigned* queue, bool skel = false) {
    const int tix = opaque_tid(), lane = tix & 63, wv = __builtin_amdgcn_readfirstlane(tix >> 6), fr = lane & 15, fq = lane >> 4;
    const float SC2 = 0.125f * LOG2E;
    volatile int* misc = (volatile int*)(smem + AT_MISC);
    for (;;) {
        __syncthreads();
        if (tix == 0) misc[0] = (int)__hip_atomic_fetch_add(queue, 1u, __ATOMIC_RELAXED, __HIP_MEMORY_SCOPE_AGENT);
        __syncthreads();
        const int u = misc[0];
        if (u >= 9 * NB * NH) break;
        const int i = 8 - u / (NB * NH), bh = u % (NB * NH), b = bh / NH, h = bh % NH;
        const size_t rowb = (size_t)b * LSEQ;
        const float* cbh = q.ct + (size_t)bh * LSEQ;
        bf16x8 qf[2][2]; float cq2[2], mrun[2], lrun[2]; f32x4 o[2][4];
#pragma unroll
        for (int qb = 0; qb < 2; ++qb) {
            const int tq = 256 * i + 32 * wv + 16 * qb + fr - 240, tqc = tq < 0 ? 0 : tq;
            const bf16_t* qp = qg + (rowb + tqc) * 2048 + h * HD + 8 * fq;
            qf[qb][0] = *(const bf16x8*)(qp); qf[qb][1] = *(const bf16x8*)(qp + 32);
            cq2[qb] = cbh[tqc] * LOG2E; mrun[qb] = -INFINITY; lrun[qb] = 0.f;
#pragma unroll
            for (int db = 0; db < 4; ++db) o[qb][db] = (f32x4){0.f, 0.f, 0.f, 0.f};
        }
        const int lr = tix >> 3, lc = tix & 7;
        const int j0 = 3, j1 = 4 * i + 3;
        u32x4 kA, vA, kB, vB, kC, vC; float cA = 0.f, cB = 0.f, cC = 0.f;
#define AT_LOAD(j, KR, VR, CR) do { const int jl_ = (j) < j1 ? (j) : j1; const int tk = 64 * jl_ - 240 + lr, tkc = tk < 0 ? 0 : tk; \
            KR = *(const u32x4*)(q.kb + (rowb + tkc) * D + h * HD + 8 * lc); \
            const int tv = 64 * jl_ - 240 + 8 * lc, tvc = tv < 0 ? 0 : tv; \
            VR = *(const u32x4*)(q.vt + ((size_t)bh * HD + lr) * LSEQ + tvc); \
            { const int tc = 64 * jl_ - 240 + (tix & 63); CR = cbh[tc < 0 ? 0 : tc]; } } while (0)
#define AT_STEP(jj, KR, VR, CR) do { unsigned char* sb = smem + buf * AT_BUF; \
            *(u32x4*)((bf16_t*)sb + lr * AT_STRIDE + 8 * lc) = KR; *(u32x4*)((bf16_t*)(sb + 64 * AT_STRIDE * 2) + lr * AT_STRIDE + 8 * lc) = VR; if (tix < 64) ((float*)(sb + 2 * 64 * AT_STRIDE * 2))[tix] = CR * -LOG2E; \
            __syncthreads(); \
            AT_LOAD((jj) + 3, KR, VR, CR); \
            if (!skel) { if ((jj) == 3 || (jj) >= 4 * i) attn_tile<true>(sb, qf, cq2, mrun, lrun, o, i, (jj), wv, lane, fr, fq); else attn_tile<false>(sb, qf, cq2, mrun, lrun, o, i, (jj), wv, lane, fr, fq); } \
            buf ^= 1; } while (0)
        AT_LOAD(j0, kA, vA, cA); AT_LOAD(j0 + 1, kB, vB, cB); AT_LOAD(j0 + 2, kC, vC, cC);
        int buf = 0;
        for (int j = j0; j <= j1; j += 3) {
            AT_STEP(j, kA, vA, cA);
            if (j + 1 <= j1) AT_STEP(j + 1, kB, vB, cB);
            if (j + 2 <= j1) AT_STEP(j + 2, kC, vC, cC);
        }
#undef AT_STEP
#undef AT_LOAD
#pragma unroll
        for (int qb = 0; qb < 2; ++qb) {
            float l = lrun[qb]; l += shfl_xor_f(l, lane, 16); l += shfl_xor_f(l, lane, 32);
            const float il = __builtin_amdgcn_rcpf(l);
            const int tq = 256 * i + 32 * wv + 16 * qb + fr - 240;
            if (tq >= 0 && !skel) {
                const size_t row = rowb + tq;
#pragma unroll
                for (int db = 0; db < 4; ++db) {
                    const int col = h * HD + 16 * db + 4 * fq;
                    const u32x2 gg = *(const u32x2*)(qg + row * 2048 + D + col);
                    const float y0 = o[qb][db][0] * il * sigmoidf_(bf2f(gg.x & 0xffffu)), y1 = o[qb][db][1] * il * sigmoidf_(bf2f(gg.x >> 16));
                    const float y2 = o[qb][db][2] * il * sigmoidf_(bf2f(gg.y & 0xffffu)), y3 = o[qb][db][3] * il * sigmoidf_(bf2f(gg.y >> 16));
                    u32x2 w; w.x = pk2(y0, y1); w.y = pk2(y2, y3);
                    *(u32x2*)(yb + row * D + col) = w;
                }
            }
        }
    }
}
#ifndef FAST_GEMM
#define FAST_GEMM 1
#endif
#ifdef PROBE_BARRIER
#define PROBE_BAR2 grid_barrier((unsigned*)(p.ws + W_CTL), ++bar_k); grid_barrier((unsigned*)(p.ws + W_CTL), ++bar_k);
#else
#define PROBE_BAR2
#endif
#ifndef FAST_SCAN
#define FAST_SCAN 1
#endif
#ifndef FAST_ATTN
#define FAST_ATTN 1
#endif
#ifndef FAST_FFN1
#define FAST_FFN1 1
#endif
constexpr int LDS_BYTES = 139264;

__device__ __forceinline__ void tail_proj(const bf16_t* __restrict__ A, const bf16_t* __restrict__ Bt, bf16_t* __restrict__ O, int ldo, int nct, int nscaled, float qs) {
    int ct = (int)blockIdx.x; asm volatile("" : "+s"(ct)); if (ct >= nct) return;
    const int tix = opaque_tid(), lane = tix & 63, w = tix >> 6, fr = lane & 15, fq = lane >> 4;
    const bf16_t* ap = A + (size_t)(TAIL0 + 16 * w + fr) * D + 8 * fq;
    const bf16_t* bp = Bt + (size_t)(16 * ct + fr) * D + 8 * fq;
    f32x4 acc = {0.f, 0.f, 0.f, 0.f};
    for (int k0 = 0; k0 < 32; k0 += 16) {
        bf16x8 a[16], b[16];
#pragma unroll
        for (int u = 0; u < 16; ++u) { a[u] = *(const bf16x8*)(ap + (k0 + u) * 32); b[u] = *(const bf16x8*)(bp + (k0 + u) * 32); }
        __builtin_amdgcn_sched_barrier(0);
#pragma unroll
        for (int u = 0; u < 16; ++u) acc = __builtin_amdgcn_mfma_f32_16x16x32_bf16(b[u], a[u], acc, 0, 0, 0);
        __builtin_amdgcn_sched_barrier(0);
    }
    const float sc = ct < nscaled ? qs : 1.f;
    u32x2 o; o.x = pk2(acc[0] * sc, acc[1] * sc); o.y = pk2(acc[2] * sc, acc[3] * sc);
    *(u32x2*)(O + (size_t)(TAIL0 + 16 * w + fr) * ldo + 16 * ct + 4 * fq) = o;
}
template <bool VT> __device__ __forceinline__ void tail_tile(const bf16_t* __restrict__ A, const bf16_t* __restrict__ Bt, bf16_t* __restrict__ O, int ldo, int ct, float sc) {
    const int tix = opaque_tid(), lane = tix & 63, w = tix >> 6, fr = lane & 15, fq = lane >> 4;
    const bf16_t* ap = A + (size_t)(TAIL0 + 16 * w + fr) * D + 8 * fq;
    const bf16_t* bp = Bt + (size_t)(16 * ct + fr) * D + 8 * fq;
    f32x4 acc = {0.f, 0.f, 0.f, 0.f};
    for (int k0 = 0; k0 < 32; k0 += 16) {
        bf16x8 a[16], b[16];
#pragma unroll
        for (int u = 0; u < 16; ++u) { a[u] = *(const bf16x8*)(ap + (k0 + u) * 32); b[u] = *(const bf16x8*)(bp + (k0 + u) * 32); }
        __builtin_amdgcn_sched_barrier(0);
#pragma unroll
        for (int u = 0; u < 16; ++u) acc = VT ? __builtin_amdgcn_mfma_f32_16x16x32_bf16(a[u], b[u], acc, 0, 0, 0)
                                             : __builtin_amdgcn_mfma_f32_16x16x32_bf16(b[u], a[u], acc, 0, 0, 0);
        __builtin_amdgcn_sched_barrier(0);
    }
    u32x2 o; o.x = pk2(acc[0] * sc, acc[1] * sc); o.y = pk2(acc[2] * sc, acc[3] * sc);
    if (VT) { const int f = 16 * ct + fr; *(u32x2*)(O + ((size_t)(7 * NH + (f >> 6)) * HD + (f & 63)) * LSEQ + (TAIL0 - 7 * LSEQ) + 16 * w + 4 * fq) = o; }
    else *(u32x2*)(O + (size_t)(TAIL0 + 16 * w + fr) * ldo + 16 * ct + 4 * fq) = o;
}
__device__ __forceinline__ void tail_kvq(const Ptrs& q, bf16_t* qg) {
    int c0 = (int)blockIdx.x; asm volatile("" : "+s"(c0));
    for (int tile = c0; tile < 256; tile += (int)gridDim.x) {
        if (tile < 64) tail_tile<false>(q.hb, q.bin, qg, 2048, tile, 0.125f * LOG2E);
        else if (tile < 128) tail_tile<false>(q.hb, q.bin, qg, 2048, tile, 1.f);
        else if (tile < 192) tail_tile<false>(q.hb, q.kv, q.kb, D, tile - 128, 1.f);
        else tail_tile<true>(q.hb, q.kv + (size_t)D * D, q.vt, 0, tile - 192, 1.f);
    }
}
__device__ __forceinline__ void grid_barrier(unsigned* ctr, unsigned k) {
    __syncthreads();
    if (opaque_tid() == 0) {
        __builtin_amdgcn_fence(__ATOMIC_RELEASE, "agent");
        const unsigned G = gridDim.x, g = blockIdx.x & 7u, ng = G < 8u ? G : 8u, cnt = (G - g + 7u) >> 3;
        const unsigned old = __hip_atomic_fetch_add(ctr + 64 + 64 * g, 1u, __ATOMIC_RELAXED, __HIP_MEMORY_SCOPE_AGENT);
        if (old == k * cnt - 1u) __hip_atomic_fetch_add(ctr, 1u, __ATOMIC_RELAXED, __HIP_MEMORY_SCOPE_AGENT);
        const unsigned target = k * ng;
        while (__hip_atomic_load(ctr, __ATOMIC_RELAXED, __HIP_MEMORY_SCOPE_AGENT) < target) __builtin_amdgcn_s_sleep(1);
        __builtin_amdgcn_fence(__ATOMIC_ACQUIRE, "agent");
    }
    __syncthreads();
}

typedef const __attribute__((address_space(4))) unsigned char* KARG;
__device__ __forceinline__ Params load_params(KARG pk) {
    const __attribute__((address_space(4))) unsigned long long* k = (const __attribute__((address_space(4))) unsigned long long*)pk;
    Params p;
    p.x = (const float*)(const __attribute__((address_space(1))) float*)k[0];    p.meta = (const float*)(const __attribute__((address_space(1))) float*)k[1];    p.a_w_in = (const float*)(const __attribute__((address_space(1))) float*)k[2];    p.a_conv_w = (const float*)(const __attribute__((address_space(1))) float*)k[3];    p.a_conv_b = (const float*)(const __attribute__((address_space(1))) float*)k[4];    p.a_w_r = (const float*)(const __attribute__((address_space(1))) float*)k[5];    p.a_b_r = (const float*)(const __attribute__((address_space(1))) float*)k[6];    p.a_w_i = (const float*)(const __attribute__((address_space(1))) float*)k[7];    p.a_b_i = (const float*)(const __attribute__((address_space(1))) float*)k[8];    p.a_lambda = (const float*)(const __attribute__((address_space(1))) float*)k[9];    p.a_w_out = (const float*)(const __attribute__((address_space(1))) float*)k[10];    p.kv_w = (const float*)(const __attribute__((address_space(1))) float*)k[11];    p.kv_f_b = (const float*)(const __attribute__((address_space(1))) float*)k[12];    p.b_w_in = (const float*)(const __attribute__((address_space(1))) float*)k[13];    p.b_w_out = (const float*)(const __attribute__((address_space(1))) float*)k[14];    p.f_w_in = (const float*)(const __attribute__((address_space(1))) float*)k[15];    p.f_conv_w = (const float*)(const __attribute__((address_space(1))) float*)k[16];    p.f_conv_b = (const float*)(const __attribute__((address_space(1))) float*)k[17];    p.f_w_out = (const float*)(const __attribute__((address_space(1))) float*)k[18];    p.ln1_g = (const float*)(const __attribute__((address_space(1))) float*)k[19];    p.ln1_b = (const float*)(const __attribute__((address_space(1))) float*)k[20];    p.ln2_g = (const float*)(const __attribute__((address_space(1))) float*)k[21];    p.ln2_b = (const float*)(const __attribute__((address_space(1))) float*)k[22];
    p.out = (float*)(__attribute__((address_space(1))) float*)k[23]; p.ws = (unsigned char*)(__attribute__((address_space(1))) unsigned char*)k[24]; p.ph_lo = 0; p.ph_hi = 0;
    return p;
}
__global__ void __launch_bounds__(512, 2) mega(Params p_in) {
    extern __shared__ __attribute__((aligned(16))) unsigned char smem[];
    LAS unsigned char* lds = (LAS unsigned char*)smem;
    const KARG pk0 = (KARG)__builtin_amdgcn_kernarg_segment_ptr();
    const int G = gridDim.x, bx = blockIdx.x, vcu = (G % 8 == 0) ? (bx % 8) * (G / 8) + bx / 8 : bx;
    const int ph_lo = p_in.ph_lo, ph_hi = p_in.ph_hi;
    int ph = 0; unsigned bar_k = 0;
#define PHASE(...) do { if (ph >= ph_lo && ph < ph_hi) { KARG pk = pk0; asm volatile("" : "+s"(pk)); const Params p = load_params(pk); const Ptrs q = make_ptrs(p); \
        bf16_t* const gr = q.big + (size_t)PADR * 3072; bf16_t* const ya = q.yb + (size_t)PADR * DR; bf16_t* const qg = q.big + (size_t)PADR * 2048; bf16_t* const yb = q.yb + (size_t)PADR * D; bf16_t* const g = q.big + (size_t)PADR * DFF; bf16_t* const mixm = q.big + (size_t)PADR * D; bf16_t* const mixf = q.yb + (size_t)PADR * D; bf16_t* const mixm2 = q.big + (size_t)(ROWS + PADR) * D; bf16_t* const mixf2 = q.hb; (void)mixm; (void)mixf; (void)mixm2; (void)mixf2; \
        (void)gr; (void)ya; (void)qg; (void)yb; (void)g; \
        __VA_ARGS__; \
        if (ph + 1 < ph_hi) { if (ph == 0) cg::this_grid().sync(); else { grid_barrier((unsigned*)(p.ws + W_CTL), ++bar_k); PROBE_BAR2 } } } ++ph; } while (0)
#define PHASE_PRE(...) do { if (ph >= ph_lo && ph < ph_hi) { KARG pk = pk0; asm volatile("" : "+s"(pk)); const Params p = load_params(pk); const Ptrs q = make_ptrs(p); \
        bf16_t* const gr = q.big + (size_t)PADR * 3072; bf16_t* const qg = q.big + (size_t)PADR * 2048; (void)gr; (void)qg; (void)p; \
        __VA_ARGS__; } } while (0)
    PHASE(prologue(p, q, (float*)smem));
#if defined(PROBE_DUP) || defined(PROBE_PRO)
    PHASE(prologue(p, q, (float*)smem));
#endif
    for (int layer = 0; layer < 4; ++layer) {
        if (layer < 2) {
            PHASE_PRE(tail_proj(q.hb, q.ain + (size_t)layer * 3072 * D, gr, 3072, 192, 0, 1.f));
            PHASE({ pg8::Sched<false> S{}; S.j0 = pg8::Job{q.hb, q.ain + (size_t)layer * 3072 * D, 64, 3072 / 256, 0, 0}; S.nj = 1; S.K = D; S.G = G; S.c = bx; S.ld = S.K;
                    pg8::EpiStore E{gr, nullptr, nullptr, 3072, 0}; pg8::gemm_phase<pg8::EpiStore, false>(lds, S, E); });
#if defined(PROBE_DUP2) || defined(PROBE_A1)
            PHASE({ pg8::Sched<false> S{}; S.j0 = pg8::Job{q.hb, q.ain + (size_t)layer * 3072 * D, MP / 256, 3072 / 256, 0, 0}; S.nj = 1; S.K = D; S.G = G; S.c = bx; S.ld = S.K;
                    pg8::EpiStore E{gr, nullptr, nullptr, 3072, 0}; pg8::gemm_phase<pg8::EpiStore, false>(lds, S, E); });
#endif
#if FAST_SCAN
            PHASE(scan_phase<1>(p, q, layer, smem));
            PHASE(carry_phase(q));
            PHASE(scan_phase<2>(p, q, layer, smem));
#if defined(PROBE_DUP) || defined(PROBE_SCAN)
            PHASE(scan_phase<1>(p, q, layer, smem));
            PHASE(scan_phase<2>(p, q, layer, smem));
#endif
#else
            PHASE(rglru_simple(gr, p.a_conv_w + (size_t)layer * 4 * DR, p.a_conv_b + (size_t)layer * DR, p.a_w_r + (size_t)layer * NLB * LB * LB, p.a_b_r + (size_t)layer * DR,
                               p.a_w_i + (size_t)layer * NLB * LB * LB, p.a_b_i + (size_t)layer * DR, p.a_lambda + (size_t)layer * DR, ya, (float*)smem));
#endif
            PHASE({ pg8::Sched<false> S{}; S.j0 = pg8::Job{ya, q.aout + (size_t)layer * D * DR, 64, D / 256, 0, 0}; S.j1 = pg8::Job{ya + (size_t)TAIL0 * DR, q.aout + (size_t)layer * D * DR, DR / 256, D / 256, 2, 256};
                    S.nj = 2; S.K = DR; S.G = G; S.c = bx; S.ld = DR;
                    pg8::EpiStore E{mixm, nullptr, q.part, D, D}; pg8::gemm_phase<pg8::EpiStore, false>(lds, S, E); });
        } else {
            const int j = layer - 2;
            if (j == 0) PHASE_PRE(tail_kvq(q, qg));
            if (j == 0) PHASE({ pg8::Sched<false> S{}; S.j0 = pg8::Job{q.hb, q.bin, 64, 8, 2, 0}; S.j1 = pg8::Job{q.hb, q.kv, 64, 4, 0, 0}; S.j2 = pg8::Job{q.kv + (size_t)D * D, q.hb, 4, 64, 1, 0};
                    S.nj = 3; S.K = D; S.G = G; S.c = bx; S.ld = S.K;
                    pg8::EpiStore E{q.kb, q.vt, qg, D, 2048, 0.125f * LOG2E}; pg8::gemm_phase<pg8::EpiStore, false>(lds, S, E);
                    cumsum_wave(q.logf, q.ct); });
            if (j != 0) PHASE_PRE(tail_proj(q.hb, q.bin + (size_t)2048 * D, qg, 2048, 128, 64, 0.125f * LOG2E));
            if (j != 0) PHASE({ pg8::Sched<false> S{}; S.j0 = pg8::Job{q.hb, q.bin + (size_t)2048 * D, 64, 8, 2, 0}; S.nj = 1; S.K = D; S.G = G; S.c = bx; S.ld = S.K;
                    pg8::EpiStore E{q.kb, q.vt, qg, D, 2048, 0.125f * LOG2E}; pg8::gemm_phase<pg8::EpiStore, false>(lds, S, E); });
#ifdef PROBE_DUP2
            if (j == 0) PHASE({ pg8::Sched<false> S{}; S.j0 = pg8::Job{q.hb, q.bin, MP / 256, 8, 2, 0}; S.j1 = pg8::Job{q.hb, q.kv, MP / 256, 4, 0, 0}; S.j2 = pg8::Job{q.kv + (size_t)D * D, q.hb, 4, MP / 256, 1, 0};
                    S.nj = 3; S.K = D; S.G = G; S.c = bx; S.ld = S.K;
                    pg8::EpiStore E{q.kb, q.vt, qg, D, 2048, 0.125f * LOG2E}; pg8::gemm_phase<pg8::EpiStore, false>(lds, S, E);
                    cumsum_wave(q.logf, q.ct); });
            else PHASE({ pg8::Sched<false> S{}; S.j0 = pg8::Job{q.hb, q.bin + (size_t)2048 * D, MP / 256, 8, 2, 0}; S.nj = 1; S.K = D; S.G = G; S.c = bx; S.ld = S.K;
                    pg8::EpiStore E{q.kb, q.vt, qg, D, 2048, 0.125f * LOG2E}; pg8::gemm_phase<pg8::EpiStore, false>(lds, S, E); });
#endif
#if defined(ATTN_NOLDS)
            PHASE(attn_phase2(q, qg, yb, smem, (unsigned*)(p.ws + W_CTL) + 16 + 16 * j));
#elif FAST_ATTN
            PHASE(attn_phase(q, qg, yb, smem, (unsigned*)(p.ws + W_CTL) + 16 + 16 * j));
#if defined(PROBE_DUP) || defined(PROBE_DUP_ATTN)
            PHASE(attn_phase(q, qg, yb, smem, (unsigned*)(p.ws + W_CTL) + 24 + 16 * j));
#endif
#if defined(PROBE_ATTN_SKEL)
            PHASE(attn_phase(q, qg, yb, smem, (unsigned*)(p.ws + W_CTL) + 24 + 16 * j, true));
#endif
#else
            PHASE(attn_simple(qg, q.kb, q.vt, q.ct, yb));
#endif
            PHASE({ pg8::Sched<false> S{}; S.j0 = pg8::Job{yb, q.bout + (size_t)j * D * D, 64, D / 256, 0, 0}; S.j1 = pg8::Job{yb + (size_t)TAIL0 * D, q.bout + (size_t)j * D * D, D / 256, D / 256, 2, 256};
                    S.nj = 2; S.K = D; S.G = G; S.c = bx; S.ld = D;
                    pg8::EpiStore E{mixm, nullptr, q.part, D, D}; pg8::gemm_phase<pg8::EpiStore, false>(lds, S, E); });
        }
        PHASE(ln_phase(p, q, q.hb, layer == 3 ? q.kb : (bf16_t*)nullptr, mixm, layer < 2 ? DR / 256 : D / 256, p.ln1_g + (size_t)layer * D, p.ln1_b + (size_t)layer * D, 0));
        PHASE({ pg8::Sched<true> S{}; S.j0 = pg8::Job{q.hb, q.fin + (size_t)layer * 5632 * D, 66, 22, 0, 0}; S.nj = 1; S.K = D; S.G = G; S.c = bx; S.ld = S.K;
                pg8::EpiFfn1 E{g, p.f_conv_w + (size_t)layer * 3 * 5632, p.f_conv_b + (size_t)layer * 5632, (LAS float*)(lds + pg8::STAGE_BYTES)}; pg8::gemm_phase<pg8::EpiFfn1, true>(lds, S, E); });
#if defined(PROBE_DUP2) || defined(PROBE_F1)
        PHASE({ pg8::Sched<true> S{}; S.j0 = pg8::Job{q.hb, q.fin + (size_t)layer * 5632 * D, 66, 22, 0, 0}; S.nj = 1; S.K = D; S.G = G; S.c = bx; S.ld = S.K;
                pg8::EpiFfn1 E{g, p.f_conv_w + (size_t)layer * 3 * 5632, p.f_conv_b + (size_t)layer * 5632, (LAS float*)(lds + pg8::STAGE_BYTES)}; pg8::gemm_phase<pg8::EpiFfn1, true>(lds, S, E); });
#endif
        PHASE({ pg8::Sched<false> S{}; S.j0 = pg8::Job{g, q.wfout + (size_t)layer * D * DFF, 64, D / 256, 0, 0}; S.j1 = pg8::Job{g + (size_t)TAIL0 * DFF, q.wfout + (size_t)layer * D * DFF, DFF / 256, D / 256, 2, 256};
                S.nj = 2; S.K = DFF; S.G = G; S.c = bx; S.ld = DFF;
                pg8::EpiStore E{mixf, nullptr, q.part, D, D}; pg8::gemm_phase<pg8::EpiStore, false>(lds, S, E); });
        PHASE(ln_phase(p, q, layer == 3 ? (const bf16_t*)q.kb : (const bf16_t*)q.hb, (bf16_t*)nullptr, mixf, DFF / 256, p.ln2_g + (size_t)layer * D, p.ln2_b + (size_t)layer * D, layer == 3 ? 2 : (layer == 1 ? 1 : 0)));
    }
#undef PHASE
}

extern "C" void kernel_launch(void* const* d_in, const int* in_sizes, int n_in, void* d_out, int out_size, void* d_ws, size_t ws_size, hipStream_t stream) {
    static int grid = 0;
    if (grid == 0) {
        int dev = 0, cus = 0, per_cu = 0;
        hipGetDevice(&dev); hipDeviceGetAttribute(&cus, hipDeviceAttributeMultiprocessorCount, dev);
        hipFuncSetAttribute((const void*)mega, hipFuncAttributeMaxDynamicSharedMemorySize, LDS_BYTES);
        hipOccupancyMaxActiveBlocksPerMultiprocessor(&per_cu, (const void*)mega, 512, LDS_BYTES);
        if (per_cu < 1) { fprintf(stderr, "kernel_launch: occupancy query says %d blocks/CU\n", per_cu); per_cu = 1; }
        grid = cus * per_cu;
        if (ws_size < W_END) fprintf(stderr, "kernel_launch: ws_size %zu < %zu\n", ws_size, (size_t)W_END);
    }
    hipMemsetAsync((unsigned char*)d_ws + W_CTL, 0, 4096, stream);
    Params p{};
    const float** f = (const float**)&p.x;
    for (int i = 0; i < 23; ++i) f[i] = (const float*)d_in[i];
    p.out = (float*)d_out; p.ws = (unsigned char*)d_ws; p.ph_lo = 0; p.ph_hi = 1000;
    void* args[] = {&p};
    hipError_t e = hipLaunchCooperativeKernel((const void*)mega, dim3(grid), dim3(512), args, LDS_BYTES, stream);
    if (e != hipSuccess) fprintf(stderr, "cooperative launch failed: %s (grid %d)\n", hipGetErrorString(e), grid);
}
```

```cpp
#include <hip/hip_runtime.h>
#include <hip/hip_cooperative_groups.h>
#include <cstdint>
#include <cstdio>
namespace cg = cooperative_groups;

typedef unsigned short bf16_t;
typedef short bf16x8 __attribute__((ext_vector_type(8)));
typedef float f32x4 __attribute__((ext_vector_type(4)));
typedef unsigned u32x4 __attribute__((ext_vector_type(4)));
typedef unsigned u32x2 __attribute__((ext_vector_type(2)));

constexpr int NB = 8, LSEQ = 2064, NMETA = 16, SEQ = 2048, M = NB * LSEQ  , MP = 16640, PADR = 16;
constexpr int D = 1024, DR = 1536, DFF = 2816, NH = 16, HD = 64, NLB = 16, LB = 96;
constexpr int NCH = 43, TCH = 48;
constexpr float ALPHA = 1.6817928305074290f;
constexpr float LN_EPS = 1e-5f;
constexpr float LOG2E = 1.4426950408889634f;

constexpr size_t ROWS = MP + PADR;
constexpr size_t O_HB = 0;
constexpr size_t O_WFOUT = O_HB + ROWS * D * 2;
constexpr size_t O_WRI = O_WFOUT + (size_t)4 * D * DFF * 2;
constexpr size_t O_AGG = O_WRI + (size_t)2 * 2 * NLB * LB * LB * 2;
constexpr size_t O_LOGF = O_AGG + (size_t)2 * NB * NCH * DR * 4;
constexpr size_t O_CT = O_LOGF + (size_t)NB * NH * LSEQ * 4;
constexpr size_t O_HIN = O_CT + (size_t)NB * NH * LSEQ * 4;
constexpr size_t O_END = O_HIN + (size_t)NB * NCH * DR * 4;
static_assert(O_END <= (size_t)NB * SEQ * D * 4, "d_out scratch map");
constexpr size_t W_CTL = 0;
constexpr size_t W_AIN = 4096;
constexpr size_t W_AOUT = W_AIN + (size_t)2 * 3072 * 1024 * 2;
constexpr size_t W_KV = W_AOUT + (size_t)2 * 1024 * 1536 * 2;
constexpr size_t W_BIN = W_KV + (size_t)2048 * 1024 * 2;
constexpr size_t W_BOUT = W_BIN + (size_t)2 * 2048 * 1024 * 2;
constexpr size_t W_FIN = W_BOUT + (size_t)2 * 1024 * 1024 * 2;
constexpr size_t W_HF = W_FIN + (size_t)4 * 5632 * 1024 * 2;
constexpr size_t W_BIG = W_HF + ROWS * D * 4;
constexpr size_t W_YB = W_BIG + ROWS * 3072 * 2;
constexpr size_t W_K = W_YB + ROWS * 1024 * 2;
constexpr size_t W_VT = W_K + ROWS * 1024 * 2;
constexpr size_t W_PART = W_VT + (size_t)NB * NH * HD * LSEQ * 2;
constexpr size_t W_END = W_PART + (size_t)11 * 256 * D * 2;
static_assert(W_END <= (size_t)369098752, "d_ws map must fit 4 x largest input");
static_assert(W_YB + ROWS * DR * 2 <= W_END, "A-layer y fits");

struct Params {
    const float *x, *meta, *a_w_in, *a_conv_w, *a_conv_b, *a_w_r, *a_b_r, *a_w_i, *a_b_i, *a_lambda, *a_w_out, *kv_w, *kv_f_b, *b_w_in, *b_w_out,
        *f_w_in, *f_conv_w, *f_conv_b, *f_w_out, *ln1_g, *ln1_b, *ln2_g, *ln2_b;
    float* out; unsigned char* ws;
    int ph_lo, ph_hi;
};

__device__ __forceinline__ unsigned f2bf(float f) { unsigned u = __builtin_bit_cast(unsigned, f); return (u + 0x7fffu + ((u >> 16) & 1u)) >> 16; }
__device__ __forceinline__ float bf2f(unsigned b) { return __builtin_bit_cast(float, b << 16); }
__device__ __forceinline__ unsigned pk2(float lo, float hi) { return f2bf(lo) | (f2bf(hi) << 16); }
__device__ __forceinline__ float sigmoidf_(float x) { return __builtin_amdgcn_rcpf(1.f + __builtin_amdgcn_exp2f(-LOG2E * x)); }
__device__ __forceinline__ float gelu_tanh(float x) { const float u = 0.7978845608028654f * (x + 0.044715f * x * x * x); return x * __builtin_amdgcn_rcpf(1.f + __builtin_amdgcn_exp2f((-2.f * LOG2E) * u)); }
__device__ __forceinline__ float log1p_pos(float x) { return x < 0.1f ? x * (1.f - x * (0.5f - x * (0.33333333f - x * 0.25f))) : __logf(1.f + x); }
__device__ __forceinline__ float neg_expm1(float y) { return y > -0.25f ? -y * (1.f + y * (0.5f + y * (0.16666667f + y * (0.041666667f + y * 0.0083333333f)))) : 1.f - __expf(y); }
__device__ __forceinline__ float shfl_xor_f(float v, int lane, int o) { return __builtin_bit_cast(float, __builtin_amdgcn_ds_bpermute((lane ^ o) << 2, __builtin_bit_cast(int, v))); }
__device__ __forceinline__ float wave_sum(float v, int lane) {
#pragma unroll
    for (int o = 32; o > 0; o >>= 1) v += shfl_xor_f(v, lane, o);
    return v;
}
__device__ __forceinline__ int opaque_tid() { int t = threadIdx.x; asm volatile("" : "+v"(t)); return t; }

struct Ptrs {
    bf16_t *hb, *wfout, *wri, *ain, *aout, *kv, *bin, *bout, *fin, *big, *yb, *kb, *vt, *part;
    float *agg, *logf, *ct, *hf, *hin; bf16_t* hlo;
};
__device__ __host__ __forceinline__ Ptrs make_ptrs(const Params& p) {
    Ptrs q; unsigned char* o = (unsigned char*)p.out; unsigned char* w = p.ws;
    q.hb = (bf16_t*)(o + O_HB) + (size_t)PADR * D; q.wfout = (bf16_t*)(o + O_WFOUT); q.wri = (bf16_t*)(o + O_WRI);
    q.agg = (float*)(o + O_AGG); q.hin = (float*)(o + O_HIN); q.logf = (float*)(o + O_LOGF); q.ct = (float*)(o + O_CT);
    q.ain = (bf16_t*)(w + W_AIN); q.aout = (bf16_t*)(w + W_AOUT); q.kv = (bf16_t*)(w + W_KV); q.bin = (bf16_t*)(w + W_BIN); q.bout = (bf16_t*)(w + W_BOUT); q.fin = (bf16_t*)(w + W_FIN);
    q.hf = (float*)(w + W_HF) + (size_t)PADR * D; q.hlo = (bf16_t*)(w + W_HF) + (size_t)PADR * D;
    q.big = (bf16_t*)(w + W_BIG);
    q.yb = (bf16_t*)(w + W_YB);
    q.kb = (bf16_t*)(w + W_K) + (size_t)PADR * D; q.vt = (bf16_t*)(w + W_VT); q.part = (bf16_t*)(w + W_PART);
    return q;
}

__device__ __forceinline__ int rowmap(int n, int mode) {
    if (mode == 0) return n;
    const int bj = n / DFF, jj = n % DFF; return (jj >> 7) * 256 + bj * 128 + (jj & 127);
}
__device__ __forceinline__ void transpose_convert(const float* __restrict__ W, int K, int N, int ldw, bf16_t* __restrict__ Wt, int mode, float* slab, int nwaves, int gwave, int lane) {
    const int tn = N / 64, nt = (K / 64) * tn;
    for (int t = gwave; t < nt; t += nwaves) {
        const int k0 = (t / tn) * 64, n0 = (t % tn) * 64;
        f32x4 v[16];
#pragma unroll
        for (int r4 = 0; r4 < 16; ++r4) v[r4] = *(const f32x4*)(W + (size_t)(k0 + r4 * 4 + (lane >> 4)) * ldw + n0 + (lane & 15) * 4);
#pragma unroll
        for (int r4 = 0; r4 < 16; ++r4)
#pragma unroll
            for (int e = 0; e < 4; ++e) slab[((lane & 15) * 4 + e) * 65 + r4 * 4 + (lane >> 4)] = v[r4][e];
#pragma unroll 4
        for (int i = 0; i < 32; ++i) { const int n = i * 2 + (lane >> 5), kp = lane & 31;
            const float a = slab[n * 65 + 2 * kp], c = slab[n * 65 + 2 * kp + 1];
            *(unsigned*)(Wt + (size_t)rowmap(n0 + n, mode) * K + k0 + 2 * kp) = pk2(a, c); }
    }
}
struct WMat { const float* W; bf16_t* Wt; int K, N, ldw, mode; };
__device__ __forceinline__ WMat wmat(const Params& p, const Ptrs& q, int m) {
    WMat r;
    if (m < 2)       { r.W = p.a_w_in + (size_t)m * D * 3072; r.Wt = q.ain + (size_t)m * 3072 * D; r.K = D; r.N = 3072; r.ldw = 3072; r.mode = 0; }
    else if (m < 4)  { const int l = m - 2; r.W = p.a_w_out + (size_t)l * DR * D; r.Wt = q.aout + (size_t)l * D * DR; r.K = DR; r.N = D; r.ldw = D; r.mode = 0; }
    else if (m < 6)  { const int l = m - 4; r.W = p.b_w_in + (size_t)l * D * 2048; r.Wt = q.bin + (size_t)l * 2048 * D; r.K = D; r.N = 2048; r.ldw = 2048; r.mode = 0; }
    else if (m < 8)  { const int l = m - 6; r.W = p.b_w_out + (size_t)l * D * D; r.Wt = q.bout + (size_t)l * D * D; r.K = D; r.N = D; r.ldw = D; r.mode = 0; }
    else if (m == 8) { r.W = p.kv_w; r.Wt = q.kv; r.K = D; r.N = 2048; r.ldw = 2064; r.mode = 0; }
    else if (m < 13) { const int l = m - 9; r.W = p.f_w_in + (size_t)l * D * 5632; r.Wt = q.fin + (size_t)l * 5632 * D; r.K = D; r.N = 5632; r.ldw = 5632; r.mode = 1; }
    else             { const int l = m - 13; r.W = p.f_w_out + (size_t)l * DFF * D; r.Wt = q.wfout + (size_t)l * D * DFF; r.K = DFF; r.N = D; r.ldw = D; r.mode = 0; }
    return r;
}
__device__ __forceinline__ int wmat_tiles(int m) { return m < 2 ? 768 : m < 4 ? 384 : m < 6 ? 512 : m < 8 ? 256 : m == 8 ? 512 : m < 13 ? 1408 : 704; }
__device__ __forceinline__ void prologue(const Params& p, const Ptrs& q, float* tile0) {
    const int gsz = gridDim.x, gid = blockIdx.x; const int tix_ = opaque_tid(), lane_ = tix_ & 63, wpb_ = blockDim.x >> 6;
    float* slab = tile0 + (tix_ >> 6) * (64 * 65);
    { const int nwaves = gsz * wpb_, gwave = gid * wpb_ + (tix_ >> 6), total = 12800;
      f32x4 vn[16]; WMat cn{}; int k0n = 0, n0n = 0;
#define PRO_FETCH(ft) do { int m_ = 0, t_ = (ft); for (; m_ < 16; ++m_) { const int c_ = wmat_tiles(m_); if (t_ < c_) break; t_ -= c_; } cn = wmat(p, q, m_); const int tn_ = cn.N / 64; k0n = (t_ / tn_) * 64; n0n = (t_ % tn_) * 64; \
          _Pragma("unroll") for (int r4 = 0; r4 < 16; ++r4) vn[r4] = *(const f32x4*)(cn.W + (size_t)(k0n + r4 * 4 + (lane_ >> 4)) * cn.ldw + n0n + (lane_ & 15) * 4); } while (0)
      if (gwave < total) PRO_FETCH(gwave);
      for (int ft = gwave; ft < total; ft += nwaves) {
          f32x4 v[16];
#pragma unroll
          for (int r4 = 0; r4 < 16; ++r4) v[r4] = vn[r4];
          const WMat c = cn; const int k0 = k0n, n0 = n0n;
          if (ft + nwaves < total) PRO_FETCH(ft + nwaves);
#pragma unroll
          for (int r4 = 0; r4 < 16; ++r4)
#pragma unroll
              for (int e = 0; e < 4; ++e) slab[((lane_ & 15) * 4 + e) * 65 + r4 * 4 + (lane_ >> 4)] = v[r4][e];
#pragma unroll 4
          for (int i = 0; i < 32; ++i) { const int n = i * 2 + (lane_ >> 5), kp = lane_ & 31;
              const float a = slab[n * 65 + 2 * kp], cc = slab[n * 65 + 2 * kp + 1];
              *(unsigned*)(c.Wt + (size_t)rowmap(n0 + n, c.mode) * c.K + k0 + 2 * kp) = pk2(a, cc); }
      }
#undef PRO_FETCH
    }
    const size_t gt = (size_t)gid * blockDim.x + opaque_tid(), gn = (size_t)gsz * blockDim.x;
    const float* const wr_src = p.a_w_r; const float* const wi_src = p.a_w_i;
    { const size_t nwri = (size_t)2 * 2 * NLB * LB * LB;
      for (size_t i0 = gt; i0 < nwri; i0 += 5 * gn) {
          float wv_[5];
#pragma unroll
          for (int u = 0; u < 5; ++u) { const size_t ii = i0 + (size_t)u * gn; const size_t i = ii < nwri ? ii : nwri - 1;
              const int c = (int)(i % LB), d = (int)((i / LB) % LB); const size_t ln = (i / (LB * LB)) % (2 * NLB); const int gate = (int)(i / ((size_t)2 * NLB * LB * LB));
              const float* src = gate ? wi_src : wr_src;
              wv_[u] = src[(ln * LB + c) * LB + d]; }
#pragma unroll
          for (int u = 0; u < 5; ++u) { const size_t ii = i0 + (size_t)u * gn; if (ii < nwri) q.wri[ii] = (bf16_t)f2bf(wv_[u]); }
      } }
    { const size_t n4 = (size_t)M * (D / 4);
      for (size_t i0 = gt; i0 < n4; i0 += 8 * gn) {
          f32x4 v[8];
#pragma unroll
          for (int u = 0; u < 8; ++u) { const size_t i = i0 + (size_t)u * gn; const size_t ic = i < n4 ? i : n4 - 1;
              const int row = (int)(ic / (D / 4)), c4 = (int)(ic % (D / 4)) * 4, b = row / LSEQ, t = row % LSEQ;
              v[u] = (t < NMETA) ? *(const f32x4*)(p.meta + (size_t)t * D + c4) : *(const f32x4*)(p.x + ((size_t)b * SEQ + (t - NMETA)) * D + c4); }
#pragma unroll
          for (int u = 0; u < 8; ++u) { const size_t i = i0 + (size_t)u * gn;
              if (i < n4) { const int row = (int)(i / (D / 4)), c4 = (int)(i % (D / 4)) * 4;
                  u32x2 w; w.x = pk2(v[u][0], v[u][1]); w.y = pk2(v[u][2], v[u][3]); *(u32x2*)(q.hb + (size_t)row * D + c4) = w;
                  u32x2 wl; wl.x = pk2(v[u][0] - bf2f(w.x & 0xffffu), v[u][1] - bf2f(w.x >> 16)); wl.y = pk2(v[u][2] - bf2f(w.y & 0xffffu), v[u][3] - bf2f(w.y >> 16)); *(u32x2*)(q.hlo + (size_t)row * D + c4) = wl; } }
      }
    }
}

constexpr int TAIL0 = 16384;
__device__ __forceinline__ void ln_phase(const Params& p, const Ptrs& q, const bf16_t* hsrc, bf16_t* hdup, const bf16_t* __restrict__ mix, int R, const float* g, const float* be, int mode) {
    const int tix = opaque_tid(), lane = tix & 63, wpb = blockDim.x >> 6, gw = (tix >> 6) * gridDim.x + blockIdx.x, nw = gridDim.x * wpb;
    u32x2 hhn[4], hln[4]; u32x2 mn[4], m2n[4];
#define LN_LOAD(r) do { _Pragma("unroll") for (int i = 0; i < 4; ++i) { const size_t o_ = (size_t)(r) * D + i * 256 + lane * 4; hhn[i] = *(const u32x2*)(hsrc + o_); hln[i] = *(const u32x2*)(q.hlo + o_); mn[i] = (r) < TAIL0 ? *(const u32x2*)(mix + o_) : *(const u32x2*)(q.part + o_ - (size_t)TAIL0 * D); m2n[i] = (u32x2){0u, 0u}; } } while (0)
    if (gw < M) LN_LOAD(gw);
    for (int row = gw; row < M; row += nw) {
        f32x4 v[4]; float s = 0.f, s2 = 0.f;
#pragma unroll
        for (int i = 0; i < 4; ++i) { const u32x2 mm = mn[i], m2 = m2n[i];
            const f32x4 hcur = (f32x4){bf2f(hhn[i].x & 0xffffu), bf2f(hhn[i].x >> 16), bf2f(hhn[i].y & 0xffffu), bf2f(hhn[i].y >> 16)} + (f32x4){bf2f(hln[i].x & 0xffffu), bf2f(hln[i].x >> 16), bf2f(hln[i].y & 0xffffu), bf2f(hln[i].y >> 16)};
            v[i] = hcur * ALPHA + ((f32x4){bf2f(mm.x & 0xffffu), bf2f(mm.x >> 16), bf2f(mm.y & 0xffffu), bf2f(mm.y >> 16)} + (f32x4){bf2f(m2.x & 0xffffu), bf2f(m2.x >> 16), bf2f(m2.y & 0xffffu), bf2f(m2.y >> 16)});
            s += v[i][0] + v[i][1] + v[i][2] + v[i][3]; s2 += v[i][0] * v[i][0] + v[i][1] * v[i][1] + v[i][2] * v[i][2] + v[i][3] * v[i][3]; }
        if (row >= TAIL0) {
            if (R == 11) {
#pragma unroll
            for (int r = 1; r < 11; ++r)
#pragma unroll
                for (int i = 0; i < 4; ++i) { const u32x2 mm = *(const u32x2*)(q.part + ((size_t)r * 256 + (row - TAIL0)) * D + i * 256 + lane * 4);
                    const f32x4 a = (f32x4){bf2f(mm.x & 0xffffu), bf2f(mm.x >> 16), bf2f(mm.y & 0xffffu), bf2f(mm.y >> 16)}; v[i] = v[i] + a; }
            } else {
#pragma unroll 5
            for (int r = 1; r < R; ++r)
#pragma unroll
                for (int i = 0; i < 4; ++i) { const u32x2 mm = *(const u32x2*)(q.part + ((size_t)r * 256 + (row - TAIL0)) * D + i * 256 + lane * 4);
                    const f32x4 a = (f32x4){bf2f(mm.x & 0xffffu), bf2f(mm.x >> 16), bf2f(mm.y & 0xffffu), bf2f(mm.y >> 16)}; v[i] = v[i] + a; }
            }
            s = 0.f; s2 = 0.f;
#pragma unroll
            for (int i = 0; i < 4; ++i) { s += v[i][0] + v[i][1] + v[i][2] + v[i][3]; s2 += v[i][0] * v[i][0] + v[i][1] * v[i][1] + v[i][2] * v[i][2] + v[i][3] * v[i][3]; }
        }
        if (row + nw < M) LN_LOAD(row + nw);
#pragma unroll
        for (int o = 32; o > 0; o >>= 1) { const float t1 = shfl_xor_f(s, lane, o), t2 = shfl_xor_f(s2, lane, o); s += t1; s2 += t2; }
        const float mu = s * (1.f / D), var = fmaxf(s2 * (1.f / D) - mu * mu, 0.f);
        const float rstd = rsqrtf(var + LN_EPS);
        const int b = row / LSEQ, t = row % LSEQ;
#pragma unroll
        for (int i = 0; i < 4; ++i) {
            const int c = i * 256 + lane * 4;
            const f32x4 gg = *(const f32x4*)(g + c), bb = *(const f32x4*)(be + c);
            v[i] = (v[i] - mu) * rstd * gg + bb;
            if (mode == 2) { if (t >= NMETA) *(f32x4*)(p.out + ((size_t)b * SEQ + (t - NMETA)) * D + c) = v[i]; }
            else { u32x2 w; w.x = pk2(v[i][0], v[i][1]); w.y = pk2(v[i][2], v[i][3]); *(u32x2*)(q.hb + (size_t)row * D + c) = w; if (hdup) *(u32x2*)(hdup + (size_t)row * D + c) = w;
                   u32x2 wl; wl.x = pk2(v[i][0] - bf2f(w.x & 0xffffu), v[i][1] - bf2f(w.x >> 16)); wl.y = pk2(v[i][2] - bf2f(w.y & 0xffffu), v[i][3] - bf2f(w.y >> 16)); *(u32x2*)(q.hlo + (size_t)row * D + c) = wl; }
        }
        if (mode == 1) {
            float acc[NH];
#pragma unroll
            for (int h = 0; h < NH; ++h) acc[h] = 0.f;
#pragma unroll 4
            for (int k = 0; k < 16; ++k) {
                    const int cidx = (k >> 2) * 256 + lane * 4 + (k & 3);
                    const float* wr = p.kv_w + (size_t)cidx * 2064 + 2048;
                    const f32x4 w0 = *(const f32x4*)(wr), w1 = *(const f32x4*)(wr + 4), w2 = *(const f32x4*)(wr + 8), w3 = *(const f32x4*)(wr + 12);
                    const float hv = bf2f(q.hb[(size_t)row * D + cidx]) + bf2f(q.hlo[(size_t)row * D + cidx]);
                    acc[0] += hv * w0[0]; acc[1] += hv * w0[1]; acc[2] += hv * w0[2]; acc[3] += hv * w0[3];
                    acc[4] += hv * w1[0]; acc[5] += hv * w1[1]; acc[6] += hv * w1[2]; acc[7] += hv * w1[3];
                    acc[8] += hv * w2[0]; acc[9] += hv * w2[1]; acc[10] += hv * w2[2]; acc[11] += hv * w2[3];
                    acc[12] += hv * w3[0]; acc[13] += hv * w3[1]; acc[14] += hv * w3[2]; acc[15] += hv * w3[3];
                }
#pragma unroll
            for (int h = 0; h < NH; ++h) {
                const float z = wave_sum(acc[h], lane) + p.kv_f_b[h];
                const float lf = fminf(z, 0.f) - log1p_pos(__expf(-fabsf(z)));
                if (lane == 0) q.logf[((size_t)b * NH + h) * LSEQ + t] = lf;
            }
        }
    }
}
#undef LN_LOAD

template <class Epi>
__device__ __forceinline__ void gemm_simple(const bf16_t* __restrict__ A, int lda, const bf16_t* __restrict__ Bt, int ldb, int Mrows, int N, int K, Epi epi) {
    const int tix = opaque_tid(), lane = tix & 63, fr = lane & 15, fq = lane >> 4;
    const int gw = (blockIdx.x * blockDim.x + tix) >> 6, nw = (gridDim.x * blockDim.x) >> 6;
    const int tn = N / 64, nt = (Mrows / 64) * tn;
    for (int tile = gw; tile < nt; tile += nw) {
        const int row0 = (tile / tn) * 64, col0 = (tile % tn) * 64;
        f32x4 acc[4][4];
#pragma unroll
        for (int i = 0; i < 4; ++i)
#pragma unroll
            for (int j = 0; j < 4; ++j) acc[i][j] = (f32x4){0.f, 0.f, 0.f, 0.f};
        for (int k0 = 0; k0 < K; k0 += 32) {
            bf16x8 a[4], b[4];
#pragma unroll
            for (int i = 0; i < 4; ++i) { a[i] = *(const bf16x8*)(A + (size_t)(row0 + 16 * i + fr) * lda + k0 + 8 * fq); b[i] = *(const bf16x8*)(Bt + (size_t)(col0 + 16 * i + fr) * ldb + k0 + 8 * fq); }
#pragma unroll
            for (int i = 0; i < 4; ++i)
#pragma unroll
                for (int j = 0; j < 4; ++j) acc[i][j] = __builtin_amdgcn_mfma_f32_16x16x32_bf16(a[i], b[j], acc[i][j], 0, 0, 0);
        }
#pragma unroll
        for (int i = 0; i < 4; ++i)
#pragma unroll
            for (int j = 0; j < 4; ++j)
#pragma unroll
                for (int e = 0; e < 4; ++e) epi(row0 + 16 * i + 4 * fq + e, col0 + 16 * j + fr, acc[i][j][e]);
    }
}
struct EStoreBf16 { bf16_t* C; int ldc; int pad; __device__ void operator()(int r, int c, float v) const { C[(size_t)r * ldc + c] = (bf16_t)f2bf(v); } };
struct EResidual { float* hf; __device__ void operator()(int r, int c, float v) const { float* p = hf + (size_t)r * D + c; *p = ALPHA * *p + v; } };
struct EKV { bf16_t* K; bf16_t* Vt; __device__ void operator()(int r, int c, float v) const {
    if (c < D) K[(size_t)r * D + c] = (bf16_t)f2bf(v);
    else if (r < M) { const int cc = c - D, h = cc >> 6, d = cc & 63, b = r / LSEQ, t = r % LSEQ; Vt[(((size_t)b * NH + h) * HD + d) * LSEQ + t] = (bf16_t)f2bf(v); } } };

__device__ __forceinline__ void ffn1_simple(const bf16_t* __restrict__ hb, const bf16_t* __restrict__ Wt  , const float* __restrict__ cw  , const float* __restrict__ cb, bf16_t* __restrict__ g  , float* zs) {
    const int tix = opaque_tid(), lane = tix & 63, fr = lane & 15, fq = lane >> 4, wv = tix >> 6;
    const int gw = (blockIdx.x * blockDim.x + tix) >> 6, nw = (gridDim.x * blockDim.x) >> 6;
    const int ngrp = (M + 61) / 62, ncg = DFF / 32, nt = ngrp * ncg;
    float* z = zs + wv * 64 * 65;
    for (int tile = gw; tile < nt; tile += nw) {
        const int base = (tile / ncg) * 62 - 2, jj0 = (tile % ncg) * 32;
        f32x4 acc[4][4];
#pragma unroll
        for (int i = 0; i < 4; ++i)
#pragma unroll
            for (int j = 0; j < 4; ++j) acc[i][j] = (f32x4){0.f, 0.f, 0.f, 0.f};
        for (int k0 = 0; k0 < D; k0 += 32) {
            bf16x8 a[4], b[4];
#pragma unroll
            for (int i = 0; i < 4; ++i) {
                a[i] = *(const bf16x8*)(hb + (long)(base + 16 * i + fr) * D + k0 + 8 * fq);
                const int jj = jj0 + 16 * (i & 1) + fr, brow = (jj >> 7) * 256 + (i >> 1) * 128 + (jj & 127);
                b[i] = *(const bf16x8*)(Wt + (size_t)brow * D + k0 + 8 * fq);
            }
#pragma unroll
            for (int i = 0; i < 4; ++i)
#pragma unroll
                for (int j = 0; j < 4; ++j) acc[i][j] = __builtin_amdgcn_mfma_f32_16x16x32_bf16(a[i], b[j], acc[i][j], 0, 0, 0);
        }
#pragma unroll
        for (int i = 0; i < 4; ++i)
#pragma unroll
            for (int j = 0; j < 4; ++j)
#pragma unroll
                for (int e = 0; e < 4; ++e) z[(16 * i + 4 * fq + e) * 65 + 16 * j + fr] = acc[i][j][e];
        const int jl = lane & 31, jj = jj0 + jl;
        const float wg0 = cw[jj], wg1 = cw[5632 + jj], wg2 = cw[2 * 5632 + jj], bg = cb[jj];
        const float wv0 = cw[DFF + jj], wv1 = cw[5632 + DFF + jj], wv2 = cw[2 * 5632 + DFF + jj], bv = cb[DFF + jj];
        for (int i = 0; i < 31; ++i) {
            const int s = 2 + 2 * i + (lane >> 5), row = base + s;
            if (row < M) {
                const int t = row % LSEQ;
                const float g2 = (t >= 2) ? z[(s - 2) * 65 + jl] : 0.f, g1 = (t >= 1) ? z[(s - 1) * 65 + jl] : 0.f, g0 = z[s * 65 + jl];
                const float v2 = (t >= 2) ? z[(s - 2) * 65 + 32 + jl] : 0.f, v1 = (t >= 1) ? z[(s - 1) * 65 + 32 + jl] : 0.f, v0 = z[s * 65 + 32 + jl];
                float zg = bg; zg += g2 * wg0; zg += g1 * wg1; zg += g0 * wg2;
                float zv = bv; zv += v2 * wv0; zv += v1 * wv1; zv += v0 * wv2;
                g[(size_t)row * DFF + jj] = (bf16_t)f2bf(gelu_tanh(zg) * zv);
            }
        }
    }
}

__device__ __forceinline__ void rglru_simple(const bf16_t* __restrict__ gr  , const float* __restrict__ conv_w  , const float* __restrict__ conv_b,
                             const float* __restrict__ w_r  , const float* __restrict__ b_r, const float* __restrict__ w_i, const float* __restrict__ b_i,
                             const float* __restrict__ lam, bf16_t* __restrict__ y  , float* xs  ) {
    const int tix = opaque_tid();
    for (int unit = blockIdx.x; unit < NB * NLB; unit += gridDim.x) {
        const int b = unit / NLB, n = unit % NLB, d = tix < LB ? tix : 0, ch = n * LB + d;
        const bool act = tix < LB;
        const float c0 = conv_w[ch], c1 = conv_w[DR + ch], c2 = conv_w[2 * DR + ch], c3 = conv_w[3 * DR + ch], cb = conv_b[ch];
        const float br = b_r[ch], bi = b_i[ch], sp = log1p_pos(__expf(-lam[ch]));
        const float* wr = w_r + (size_t)n * LB * LB + d; const float* wi = w_i + (size_t)n * LB * LB + d;
        float r0 = 0.f, r1 = 0.f, r2 = 0.f, h = 0.f;
        for (int t = 0; t < LSEQ; ++t) {
            const size_t row = (size_t)b * LSEQ + t;
            float x = 0.f;
            if (act) {
                const float raw = bf2f(gr[row * 3072 + DR + ch]);
                x = cb; x += r0 * c0; x += r1 * c1; x += r2 * c2; x += raw * c3;
                r0 = r1; r1 = r2; r2 = raw;
                xs[(t & 1) * LB + d] = x;
            }
            __syncthreads();
            if (act) {
                float pr = 0.f, pi = 0.f;
                for (int c = 0; c < LB; ++c) { const float xc = xs[(t & 1) * LB + c]; pr += xc * wr[c * LB]; pi += xc * wi[c * LB]; }
                const float r = sigmoidf_(pr + br), ig = sigmoidf_(pi + bi);
                const float la = -8.f * r * sp, a = __expf(la), u = sqrtf(neg_expm1(2.f * la)) * (ig * x);
                h = a * h + u;
                const float gate = bf2f(gr[row * 3072 + ch]);
                y[row * DR + ch] = (bf16_t)f2bf(gelu_tanh(gate) * h);
            }
        }
        __syncthreads();
    }
}

__device__ __forceinline__ void cumsum_simple(const float* __restrict__ logf, float* __restrict__ ct) {
    if (blockIdx.x != gridDim.x - 1) return;
    const int i = opaque_tid(); if (i >= NB * NH) return;
    float c = 0.f; for (int t = 0; t < LSEQ; ++t) { c += logf[(size_t)i * LSEQ + t]; ct[(size_t)i * LSEQ + t] = c; }
}

__device__ __forceinline__ void attn_simple(const bf16_t* __restrict__ qg  , const bf16_t* __restrict__ kb, const bf16_t* __restrict__ vt, const float* __restrict__ ct, bf16_t* __restrict__ y  ) {
    for (int idx = blockIdx.x * blockDim.x + opaque_tid(); idx < NB * NH * LSEQ; idx += gridDim.x * blockDim.x) {
        const int tq = idx % LSEQ, bh = idx / LSEQ, b = bh / NH, h = bh % NH;
        const size_t row = (size_t)b * LSEQ + tq;
        float qv[HD], o[HD];
#pragma unroll
        for (int d = 0; d < HD; ++d) { qv[d] = bf2f(qg[row * 2048 + h * HD + d]); o[d] = 0.f; }
        const float cq = ct[(size_t)bh * LSEQ + tq];
        float m = -INFINITY, l = 0.f;
        for (int s = 0; s <= tq; ++s) {
            const bf16_t* kr = kb + ((size_t)b * LSEQ + s) * D + h * HD;
            float dot = 0.f;
#pragma unroll
            for (int d = 0; d < HD; ++d) dot += qv[d] * bf2f(kr[d]);
            const float logit = dot * 0.125f + (cq - ct[(size_t)bh * LSEQ + s]);
            const float mn = fmaxf(m, logit), sc = __expf(m - mn), pp = __expf(logit - mn);
            l = l * sc + pp; m = mn;
#pragma unroll
            for (int d = 0; d < HD; ++d) o[d] = o[d] * sc + pp * bf2f(vt[((size_t)bh * HD + d) * LSEQ + s]);
        }
        const float il = 1.f / l;
#pragma unroll
        for (int d = 0; d < HD; ++d) { const float gt = bf2f(qg[row * 2048 + D + h * HD + d]); y[row * D + h * HD + d] = (bf16_t)f2bf(o[d] * il * sigmoidf_(gt)); }
    }
}

__device__ __forceinline__ void cumsum_wave(const float* __restrict__ logf, float* __restrict__ ct) {
    const int tix = opaque_tid(), lane = tix & 63, wv = tix >> 6;
    const int seq = wv * (int)gridDim.x + ((int)gridDim.x - 1 - (int)blockIdx.x);
    if (seq >= NB * NH) return;
    const float* src = logf + (size_t)seq * LSEQ; float* dst = ct + (size_t)seq * LSEQ;
    const int t0 = lane * 33;
    float v[33];
#pragma unroll
    for (int k = 0; k < 33; ++k) { const int t = t0 + k; v[k] = src[t < LSEQ ? t : LSEQ - 1]; if (t >= LSEQ) v[k] = 0.f; }
#pragma unroll
    for (int k = 1; k < 33; ++k) v[k] += v[k - 1];
    const float total = v[32]; float incl = total;
#pragma unroll
    for (int d = 1; d < 64; d <<= 1) { const float y = __builtin_bit_cast(float, __builtin_amdgcn_ds_bpermute(((lane - d) & 63) << 2, __builtin_bit_cast(int, incl))); const float m = lane >= d ? 1.f : 0.f; incl += y * m; }
    const float excl = incl - total;
#pragma unroll
    for (int k = 0; k < 33; ++k) { const int t = t0 + k; if (t < LSEQ) dst[t] = v[k] + excl; }
}
#define LAS __attribute__((address_space(3)))
namespace pg8 {
constexpr int BM = 256, BK = 64, HALF = 128, HTB = HALF * BK * 2, STAGE_BYTES = 8 * HTB, NXCD = 8, WGM = 8;
__device__ __forceinline__ int lds_byte(int r, int c) { const int st = (r >> 4) * 2 + (c >> 5), rr = r & 15, cc = c & 31, ob = rr * 64 + cc * 2; return st * 1024 + (ob ^ (((ob >> 9) & 1) << 5)); }
__device__ __forceinline__ void stage_rc(int b, int& R, int& C) { const int st = b / 1024, sb = b % 1024, swz = sb ^ (((sb >> 9) & 1) << 5); R = (st >> 1) * 16 + swz / 64; C = (st & 1) * 32 + (swz % 64) / 2; }
__device__ __forceinline__ int perm32(int rho) { const int n = rho >> 4, i = rho & 15; return 8 * (i >> 2) + 4 * n + (i & 3); }

struct Job { const bf16_t* A; const bf16_t* Bt; int nM, nN, id, kpiece; };
struct Unit { const char* A; const char* B; int pm, pn, job, nt; };
template <bool OVL> struct Sched {
    Job j0, j1, j2; int nj, K, G, c, ld;
    __device__ __forceinline__ bool next(int i, Unit& u) const {
        long L = (long)i * G + c;
        const int n0 = j0.nM * j0.nN, n1 = nj > 1 ? j1.nM * j1.nN : 0, n2 = nj > 2 ? j2.nM * j2.nN : 0;
        if (L >= (long)n0 + n1 + n2) return false;
        const int sel = L < n0 ? 0 : (L < n0 + n1 ? 1 : 2);
        if (sel == 1) L -= n0; else if (sel == 2) L -= n0 + n1;
        const bf16_t *A0 = j0.A, *A1 = j1.A, *A2 = j2.A, *B0 = j0.Bt, *B1 = j1.Bt, *B2 = j2.Bt;
        const int M0 = j0.nM, M1 = j1.nM, M2 = j2.nM, N0 = j0.nN, N1 = j1.nN, N2 = j2.nN, I0 = j0.id, I1 = j1.id, I2 = j2.id, P0 = j0.kpiece, P1 = j1.kpiece, P2 = j2.kpiece;
        const bf16_t* jA = sel == 0 ? A0 : (sel == 1 ? A1 : A2); const bf16_t* jB = sel == 0 ? B0 : (sel == 1 ? B1 : B2);
        const int nM = sel == 0 ? M0 : (sel == 1 ? M1 : M2), nN = sel == 0 ? N0 : (sel == 1 ? N1 : N2), nwg = nM * nN;
        u.job = sel == 0 ? I0 : (sel == 1 ? I1 : I2); const int kp = sel == 0 ? P0 : (sel == 1 ? P1 : P2);
        int wgid = (int)L; { const int q = nwg / NXCD, r = nwg % NXCD, xcd = wgid % NXCD, off = wgid / NXCD; wgid = (xcd < r ? xcd * (q + 1) : r * (q + 1) + (xcd - r) * q) + off; }
        const int nig = WGM * nN, gid = wgid / nig, fm = gid * WGM, gsz = (nM - fm) < WGM ? (nM - fm) : WGM;
        u.pm = fm + ((wgid % nig) % gsz); u.pn = (wgid % nig) / gsz;
        u.A = (const char*)jA + (kp ? (long)u.pm * kp * 2 : (OVL ? ((long)u.pm * 252 - 2) : (long)u.pm * 256) * ld * 2);
        u.B = (const char*)jB + (long)u.pn * 256 * ld * 2 + (kp ? (long)u.pm * kp * 2 : 0L);
        u.nt = (kp ? kp : K) / BK;
        return true;
    }
};

template <class Epi, bool OVL>
__device__ __forceinline__ void gemm_phase(LAS unsigned char* lds, const Sched<OVL> S, const Epi E) {
    const int wid = __builtin_amdgcn_readfirstlane(opaque_tid() >> 6), wr = wid >> 2, wc = wid & 3;
    const int K = S.ld;
    unsigned voffA[2], voffB[2]; int aoff, boff;
#define PG8_LANE_SETUP() do { const int tid = opaque_tid(), lane = tid & 63, fr = lane & 15, fq = lane >> 4; \
        _Pragma("unroll") for (int i = 0; i < 2; ++i) { int R, C; stage_rc(tid * 16 + i * 8192, R, C); const int Rb = Epi::PERM ? ((R & ~31) + perm32(R & 31)) : R; const int Ra = OVL ? (R + 62 * (R >> 6)) : R; \
            voffA[i] = (unsigned)(Ra * K + C) * 2u; voffB[i] = (unsigned)(Rb * K + C) * 2u; } \
        aoff = lds_byte(wr * 64 + fr, fq * 8); boff = lds_byte(wc * 32 + fr, fq * 8); } while (0)
    PG8_LANE_SETUP();
    const size_t kstep = (size_t)(BK * 2);
    const size_t hstep = (size_t)HALF * K * 2;
    const size_t hstepA = OVL ? (size_t)64 * K * 2 : hstep;
    const unsigned ldsw = (unsigned)wid * 1024u;
#define PG8_SA(b, h) (((b) * 2 + (h)) * HTB)
#define PG8_SB(b, h) ((4 + (b) * 2 + (h)) * HTB)
#define PG8_STAGE(bufoff, gbase, voff) do { _Pragma("unroll") for (int _i = 0; _i < 2; ++_i) \
        __builtin_amdgcn_global_load_lds((const unsigned*)((const char*)(gbase) + (voff)[_i]), (LAS unsigned*)(lds + (bufoff) + ldsw + _i * 8192), 16, 0, 0); } while (0)
#define PG8_LDA(dst, b, h) do { _Pragma("unroll") for (int m = 0; m < 4; ++m) _Pragma("unroll") for (int k = 0; k < 2; ++k) dst[m][k] = *(const LAS bf16x8*)(lds + PG8_SA(b, h) + aoff + m * 2048 + k * 1024); } while (0)
#define PG8_LDB(dst, b, h) do { _Pragma("unroll") for (int n = 0; n < 2; ++n) _Pragma("unroll") for (int k = 0; k < 2; ++k) dst[n][k] = *(const LAS bf16x8*)(lds + PG8_SB(b, h) + boff + n * 2048 + k * 1024); } while (0)
#define PG8_MMA(ai, bj, At, Bt) do { __builtin_amdgcn_s_setprio(1); _Pragma("unroll") for (int m = 0; m < 4; ++m) _Pragma("unroll") for (int n = 0; n < 2; ++n) _Pragma("unroll") for (int k = 0; k < 2; ++k) \
        acc[ai][bj][m][n] = __builtin_amdgcn_mfma_f32_16x16x32_bf16(Bt[n][k], At[m][k], acc[ai][bj][m][n], 0, 0, 0); __builtin_amdgcn_s_setprio(0); } while (0)
#define PG8_WAIT_V(n) asm volatile("s_waitcnt vmcnt(" #n ")" ::: "memory")
#define PG8_WAIT_L(n) asm volatile("s_waitcnt lgkmcnt(" #n ")" ::: "memory")
#define PG8_BAR __builtin_amdgcn_s_barrier()
#define PG8_SCHED __builtin_amdgcn_sched_barrier(0)
    Unit cur, nxt; int ui = 0;
    if (!S.next(0, cur)) return;
    f32x4 acc[2][2][4][2];
#pragma unroll
    for (int a = 0; a < 2; ++a)
#pragma unroll
        for (int b = 0; b < 2; ++b)
#pragma unroll
            for (int m = 0; m < 4; ++m)
#pragma unroll
                for (int n = 0; n < 2; ++n) acc[a][b][m][n] = (f32x4){0.f, 0.f, 0.f, 0.f};
    bf16x8 At[4][2], B0[2][2], B1[2][2];
    const char* cA = cur.A; const char* cB = cur.B;
    PG8_STAGE(PG8_SB(0, 0), cB, voffB); PG8_STAGE(PG8_SB(0, 1), cB + hstep, voffB); PG8_STAGE(PG8_SA(0, 0), cA, voffA); PG8_STAGE(PG8_SA(0, 1), cA + hstepA, voffA);
    if (wr == 1) PG8_BAR;
    PG8_WAIT_V(2); PG8_BAR;
    PG8_STAGE(PG8_SB(1, 0), cB + kstep, voffB); PG8_STAGE(PG8_SA(1, 0), cA + kstep, voffA); PG8_STAGE(PG8_SB(1, 1), cB + hstep + kstep, voffB);
    PG8_WAIT_V(6); PG8_BAR;
    for (;;) {
        const bool has_next = S.next(ui + 1, nxt);
        const char* nA = has_next ? nxt.A : cA; const char* nB = has_next ? nxt.B : cB;
        const int nt = cur.nt;
        for (int t = 0; t < nt; t += 2) {
            const bool last = (t == nt - 2);
            const char* a1 = cA + (size_t)(t + 1) * kstep;
            const char* a2 = last ? nA : cA + (size_t)(t + 2) * kstep; const char* b2 = last ? nB : cB + (size_t)(t + 2) * kstep;
            const char* a3 = a2 + kstep; const char* b3 = b2 + kstep;
            PG8_LDB(B0, 0, 0); PG8_LDB(B1, 0, 1); PG8_SCHED; PG8_LDA(At, 0, 0); PG8_STAGE(PG8_SA(1, 1), a1 + hstepA, voffA);
            PG8_WAIT_V(8); PG8_WAIT_L(0); PG8_BAR; PG8_MMA(0, 0, At, B0); PG8_MMA(0, 1, At, B1); PG8_BAR; PG8_SCHED;
            PG8_LDA(At, 0, 1); PG8_STAGE(PG8_SB(0, 0), b2, voffB); PG8_STAGE(PG8_SB(0, 1), b2 + hstep, voffB); PG8_STAGE(PG8_SA(0, 0), a2, voffA);
            PG8_WAIT_V(8); PG8_WAIT_L(0); PG8_BAR; PG8_MMA(1, 0, At, B0); PG8_MMA(1, 1, At, B1); PG8_BAR; PG8_SCHED;
            PG8_LDB(B0, 1, 0); PG8_LDB(B1, 1, 1); PG8_SCHED; PG8_LDA(At, 1, 0); PG8_STAGE(PG8_SA(0, 1), a2 + hstepA, voffA);
            PG8_WAIT_V(8); PG8_WAIT_L(0); PG8_BAR; PG8_MMA(0, 0, At, B0); PG8_MMA(0, 1, At, B1); PG8_BAR; PG8_SCHED;
            PG8_LDA(At, 1, 1); PG8_STAGE(PG8_SB(1, 0), b3, voffB); PG8_STAGE(PG8_SB(1, 1), b3 + hstep, voffB); PG8_STAGE(PG8_SA(1, 0), a3, voffA);
            PG8_WAIT_V(8); PG8_WAIT_L(0); PG8_BAR; PG8_MMA(1, 0, At, B0); PG8_MMA(1, 1, At, B1); PG8_BAR; PG8_SCHED;
        }
        if (wr == 0) PG8_BAR;
        E(acc, cur, wr, wc);
        if (!has_next) break;
#pragma unroll
        for (int a = 0; a < 2; ++a)
#pragma unroll
            for (int b = 0; b < 2; ++b)
#pragma unroll
                for (int m = 0; m < 4; ++m)
#pragma unroll
                    for (int n = 0; n < 2; ++n) acc[a][b][m][n] = (f32x4){0.f, 0.f, 0.f, 0.f};
        cur = nxt; cA = nA; cB = nB; ++ui;
        PG8_LANE_SETUP();
        if (wr == 1) PG8_BAR;
    }
    PG8_WAIT_V(0);
    PG8_BAR;
#undef PG8_LANE_SETUP
#undef PG8_SA
#undef PG8_SB
#undef PG8_STAGE
#undef PG8_LDA
#undef PG8_LDB
#undef PG8_MMA
#undef PG8_WAIT_V
#undef PG8_WAIT_L
#undef PG8_BAR
#undef PG8_SCHED
}

__device__ __forceinline__ unsigned cvt_pk_bf16(float lo, float hi) { unsigned r; asm volatile("v_cvt_pk_bf16_f32 %0, %1, %2" : "=v"(r) : "v"(lo), "v"(hi)); return r; }
__device__ __forceinline__ u32x4 pack8(const f32x4& v0, const f32x4& v1) { u32x4 w; w.x = cvt_pk_bf16(v0[0], v0[1]); w.y = cvt_pk_bf16(v0[2], v0[3]); w.z = cvt_pk_bf16(v1[0], v1[1]); w.w = cvt_pk_bf16(v1[2], v1[3]); return w; }

struct EpiStore { static constexpr bool PERM = true;
    bf16_t* O0; bf16_t* Vt; bf16_t* O2; int ld0, ld2; float qs = 1.f;
    __device__ __forceinline__ void operator()(f32x4 (&acc)[2][2][4][2], const Unit& u, int wr, int wc) const {
        const int lane_ = opaque_tid() & 63, fr = lane_ & 15, fq = lane_ >> 4;
        const int row0 = u.pm * BM + wr * 64 + fr, col0 = u.pn * BM + wc * 32 + 8 * fq;
        if (u.job == 1) {
#pragma unroll
            for (int bj = 0; bj < 2; ++bj) { const int tok = col0 + bj * HALF; if (tok < M) { const int b = tok / LSEQ, t = tok % LSEQ;
#pragma unroll
                for (int ai = 0; ai < 2; ++ai)
#pragma unroll
                    for (int m = 0; m < 4; ++m) { const int f = row0 + ai * HALF + m * 16; *(u32x4*)(Vt + ((size_t)(b * NH + (f >> 6)) * HD + (f & 63)) * LSEQ + t) = pack8(acc[ai][bj][m][0], acc[ai][bj][m][1]); } } }
        } else {
            bf16_t* O = u.job == 0 ? O0 : O2; const int ldc = u.job == 0 ? ld0 : ld2;
            if (u.job == 2 && qs != 1.f && u.pn < 4) {
#pragma unroll
                for (int ai = 0; ai < 2; ++ai)
#pragma unroll
                    for (int m = 0; m < 4; ++m) { bf16_t* rowp = O + (size_t)(row0 + ai * HALF + m * 16) * ldc + col0;
#pragma unroll
                        for (int bj = 0; bj < 2; ++bj) *(u32x4*)(rowp + bj * HALF) = pack8(acc[ai][bj][m][0] * qs, acc[ai][bj][m][1] * qs); }
            } else
#pragma unroll
            for (int ai = 0; ai < 2; ++ai)
#pragma unroll
                for (int m = 0; m < 4; ++m) { bf16_t* rowp = O + (size_t)(row0 + ai * HALF + m * 16) * ldc + col0;
#pragma unroll
                    for (int bj = 0; bj < 2; ++bj) *(u32x4*)(rowp + bj * HALF) = pack8(acc[ai][bj][m][0], acc[ai][bj][m][1]); }
        }
    }
};
struct EpiResidual { static constexpr bool PERM = false;
    float* hf;
    __device__ __forceinline__ void operator()(f32x4 (&acc)[2][2][4][2], const Unit& u, int wr, int wc) const {
        const int lane_ = opaque_tid() & 63, fr = lane_ & 15, fq = lane_ >> 4;
        const int row0 = u.pm * BM + wr * 64 + fr, col0 = u.pn * BM + wc * 32 + 4 * fq;
#pragma unroll
        for (int ai = 0; ai < 2; ++ai)
#pragma unroll
            for (int m = 0; m < 4; ++m) { float* rowp = hf + (size_t)(row0 + ai * HALF + m * 16) * D + col0;
#pragma unroll
                for (int bj = 0; bj < 2; ++bj)
#pragma unroll
                    for (int n = 0; n < 2; ++n) { f32x4* pp = (f32x4*)(rowp + bj * HALF + n * 16); *pp = *pp * ALPHA + acc[ai][bj][m][n]; }
                __builtin_amdgcn_sched_barrier(0); }
    }
};
template <int CTRL> __device__ __forceinline__ float dpp_old(float old, float x) { return __builtin_bit_cast(float, __builtin_amdgcn_update_dpp(__builtin_bit_cast(int, old), __builtin_bit_cast(int, x), CTRL, 0xf, 0xf, false)); }
template <int CTRL> __device__ __forceinline__ float dppf(float x) { return __builtin_bit_cast(float, __builtin_amdgcn_update_dpp(0, __builtin_bit_cast(int, x), CTRL, 0xf, 0xf, true)); }
struct EpiFfn1 { static constexpr bool PERM = true;
    bf16_t* g; const float* cw; const float* cb; LAS float* cwl;
    __device__ __forceinline__ void operator()(f32x4 (&acc)[2][2][4][2], const Unit& u, int wr, int wc) const {
        const int lane_ = opaque_tid() & 63, fr = lane_ & 15, fq = lane_ >> 4;
        const int G0 = u.pm * 252 + wr * 126 - 2, jj0 = u.pn * 128 + wc * 32 + 8 * fq;
        { const int tid = opaque_tid();
#pragma unroll
          for (int i = 0; i < 2; ++i) { const int idx = tid + 512 * i, k = idx >> 8, c = idx & 255, ch = (c >> 7) * DFF + u.pn * 128 + (c & 127);
              cwl[idx] = k < 3 ? cw[k * 5632 + ch] : cb[ch]; }
          asm volatile("s_waitcnt lgkmcnt(0)" ::: "memory"); __builtin_amdgcn_s_barrier(); asm volatile("" ::: "memory"); }
        const int cl0 = wc * 32 + 8 * fq;
#pragma unroll
        for (int blk = 0; blk < 8; ++blk) {
            const int ai = blk >> 2, m = blk & 3, off = 64 * ai + 16 * m + fr, row = G0 + off; const unsigned t = (unsigned)(row + LSEQ) % (unsigned)LSEQ;
            const float tm1 = t >= 1u ? 1.f : 0.f, tm2 = t >= 2u ? 1.f : 0.f;
            f32x4 o[2];
#pragma unroll
            for (int n = 0; n < 2; ++n) {
                f32x4 cv[2];
#pragma unroll
                for (int bj = 0; bj < 2; ++bj) {
                    const int ci = bj * 128 + cl0 + 4 * n;
                    const f32x4 w0 = *(const LAS f32x4*)(cwl + ci), w1 = *(const LAS f32x4*)(cwl + 256 + ci), w2 = *(const LAS f32x4*)(cwl + 512 + ci), bb = *(const LAS f32x4*)(cwl + 768 + ci);
                    const f32x4 cur = acc[ai][bj][m][n]; const f32x4 prev = blk > 0 ? acc[(blk > 0 ? blk - 1 : 0) >> 2][bj][(blk > 0 ? blk - 1 : 0) & 3][n] : (f32x4){0.f, 0.f, 0.f, 0.f};
#pragma unroll
                    for (int e = 0; e < 4; ++e) {
                        const float mp = dppf<0x140>(prev[e]), mps = dppf<0xB1>(mp);
                        const float s1 = dppf<0x111>(cur[e]), s2 = dppf<0x112>(cur[e]);
                        float p1 = fr >= 1 ? s1 : mp, p2 = fr >= 2 ? s2 : mps;
                        p1 = t >= 1u ? p1 : 0.f; p2 = t >= 2u ? p2 : 0.f;
                        float r = bb[e]; r += p2 * w0[e]; r += p1 * w1[e]; r += cur[e] * w2[e]; cv[bj][e] = r;
                    }
                }
#pragma unroll
                for (int e = 0; e < 4; ++e) o[n][e] = gelu_tanh(cv[0][e]) * cv[1][e];
            }
            if (off >= 2 && row < M) *(u32x4*)(g + (size_t)row * DFF + jj0) = pack8(o[0], o[1]);
            __builtin_amdgcn_sched_barrier(0);
        }
    }
};
}
constexpr int SC_WSM = 0, SC_PAR = 2 * LB * 104 * 2  , SC_WAVE = SC_PAR + 3 * LB * 4  , SC_WSTRIDE = 16 * 100 * 4 + 16 * 104 * 2  ;
static_assert(SC_WAVE + 8 * SC_WSTRIDE <= 139264, "scan LDS");
template <int CTRL> __device__ __forceinline__ float dpp_id1(float x) { return __builtin_bit_cast(float, __builtin_amdgcn_update_dpp(0x3f800000, __builtin_bit_cast(int, x), CTRL, 0xf, 0xf, false)); }
template <int PASS>
__device__ __forceinline__ void scan_phase(const Params& p, const Ptrs& q, int layer, unsigned char* smem) {
    const int tix = opaque_tid(), lane = tix & 63, wv = __builtin_amdgcn_readfirstlane(tix >> 6), fr = lane & 15, fq = lane >> 4;
    bf16_t* wsm = (bf16_t*)(smem + SC_WSM); float* par = (float*)(smem + SC_PAR);
    float* xs = (float*)(smem + SC_WAVE + wv * SC_WSTRIDE); bf16_t* xb = (bf16_t*)(smem + SC_WAVE + wv * SC_WSTRIDE + 6400);
    const bf16_t* gr = q.big + (size_t)PADR * 3072; bf16_t* ya = q.yb + (size_t)PADR * DR;
    float* aggA = q.agg; float* aggH = q.agg + (size_t)NB * NCH * DR;
    const float* conv_w = p.a_conv_w + (size_t)layer * 4 * DR; const float* conv_b = p.a_conv_b + (size_t)layer * DR;
    int cur_n = -1;
    for (int bu = blockIdx.x; bu < NLB * NCH; bu += gridDim.x) {
        const int n = bu % NLB, g = bu / NLB;
        const int pidx = 8 * g + wv, b = pidx / NCH, c = pidx % NCH, t0 = TCH * c;
        const bool cl = lane < 48; const int chp = n * LB + 2 * (cl ? lane : 0);
        const bf16_t* rp0 = gr + ((size_t)b * LSEQ + t0) * 3072 + DR + chp;
        unsigned rawn[16];
#pragma unroll
        for (int tt = 0; tt < 16; ++tt) rawn[tt] = *(const unsigned*)(rp0 + (size_t)tt * 3072);
        const unsigned u0 = (t0 >= 3) ? *(const unsigned*)(rp0 - 3 * 3072) : 0u, u1 = (t0 >= 2) ? *(const unsigned*)(rp0 - 2 * 3072) : 0u, u2 = (t0 >= 1) ? *(const unsigned*)(rp0 - 3072) : 0u;
        if (n != cur_n) {
            __syncthreads();
            for (int i = tix; i < 2 * LB * 12; i += 512) { const int gate = i / (LB * 12), rem = i % (LB * 12), d = rem / 12, c8 = rem % 12;
                *(u32x4*)(wsm + (gate * LB + d) * 104 + c8 * 8) = *(const u32x4*)(q.wri + ((((size_t)gate * 2 + layer) * NLB + n) * LB + d) * LB + c8 * 8); }
            if (tix < LB) { const int ch = layer * DR + n * LB + tix; par[tix] = p.a_b_r[ch]; par[LB + tix] = p.a_b_i[ch]; par[2 * LB + tix] = log1p_pos(__expf(-p.a_lambda[ch])); }
            __syncthreads();
            cur_n = n;
        }
        float cw0[2], cw1[2], cw2[2], cw3[2], cbv[2], h0[2], h1[2], h2[2];
#pragma unroll
        for (int e = 0; e < 2; ++e) { cw0[e] = conv_w[chp + e]; cw1[e] = conv_w[DR + chp + e]; cw2[e] = conv_w[2 * DR + chp + e]; cw3[e] = conv_w[3 * DR + chp + e]; cbv[e] = conv_b[chp + e]; }
        h0[0] = bf2f(u0 & 0xffffu); h0[1] = bf2f(u0 >> 16); h1[0] = bf2f(u1 & 0xffffu); h1[1] = bf2f(u1 >> 16); h2[0] = bf2f(u2 & 0xffffu); h2[1] = bf2f(u2 >> 16);
        f32x4 hc[6], Ac[6];
#pragma unroll
        for (int db = 0; db < 6; ++db) { hc[db] = (f32x4){0.f, 0.f, 0.f, 0.f}; Ac[db] = (f32x4){1.f, 1.f, 1.f, 1.f}; }
        if (PASS == 2) {
#pragma unroll
            for (int db = 0; db < 6; ++db) hc[db] = *(const f32x4*)(q.hin + ((size_t)b * NCH + c) * DR + n * LB + 16 * db + 4 * fq);
        }
        for (int s = 0; s < 3; ++s) {
            const size_t rowb = (size_t)b * LSEQ + t0 + 16 * s;
            unsigned raw[16];
#pragma unroll
            for (int tt = 0; tt < 16; ++tt) raw[tt] = rawn[tt];
            if (s < 2) {
#pragma unroll
                for (int tt = 0; tt < 16; ++tt) rawn[tt] = *(const unsigned*)(rp0 + (size_t)(16 * (s + 1) + tt) * 3072);
            }
            u32x2 gg[6];
            if (PASS == 2) {
#pragma unroll
                for (int db = 0; db < 6; ++db) gg[db] = *(const u32x2*)(gr + (rowb + fr) * 3072 + n * LB + 16 * db + 4 * fq);
            }
            if (cl) {
#pragma unroll
                for (int tt = 0; tt < 16; ++tt) {
                    const unsigned uu = raw[tt]; const float r0 = bf2f(uu & 0xffffu), r1 = bf2f(uu >> 16);
                    float x0 = cbv[0]; x0 += h0[0] * cw0[0]; x0 += h1[0] * cw1[0]; x0 += h2[0] * cw2[0]; x0 += r0 * cw3[0];
                    float x1 = cbv[1]; x1 += h0[1] * cw0[1]; x1 += h1[1] * cw1[1]; x1 += h2[1] * cw2[1]; x1 += r1 * cw3[1];
                    h0[0] = h1[0]; h1[0] = h2[0]; h2[0] = r0; h0[1] = h1[1]; h1[1] = h2[1]; h2[1] = r1;
                    xs[tt * 100 + 2 * lane] = x0; xs[tt * 100 + 2 * lane + 1] = x1;
                    *(unsigned*)(xb + tt * 104 + 2 * lane) = pg8::cvt_pk_bf16(x0, x1);
                }
            }
            asm volatile("s_waitcnt lgkmcnt(0)" ::: "memory");
            bf16x8 xf[3];
#pragma unroll
            for (int ks = 0; ks < 3; ++ks) xf[ks] = *(const bf16x8*)(xb + fr * 104 + 32 * ks + 8 * fq);
#pragma unroll
            for (int db = 0; db < 6; ++db) {
                f32x4 pr = (f32x4){0.f, 0.f, 0.f, 0.f}, pi = (f32x4){0.f, 0.f, 0.f, 0.f};
#pragma unroll
                for (int ks = 0; ks < 3; ++ks) {
                    const bf16x8 ar = *(const bf16x8*)(wsm + (16 * db + fr) * 104 + 32 * ks + 8 * fq), ai = *(const bf16x8*)(wsm + (LB + 16 * db + fr) * 104 + 32 * ks + 8 * fq);
                    pr = __builtin_amdgcn_mfma_f32_16x16x32_bf16(ar, xf[ks], pr, 0, 0, 0); pi = __builtin_amdgcn_mfma_f32_16x16x32_bf16(ai, xf[ks], pi, 0, 0, 0);
                }
                const int d0 = 16 * db + 4 * fq;
                const f32x4 br4 = *(const f32x4*)(par + d0), bi4 = *(const f32x4*)(par + LB + d0), sp4 = *(const f32x4*)(par + 2 * LB + d0), x4 = *(const f32x4*)(xs + fr * 100 + d0);
                f32x4 hv;
#pragma unroll
                for (int j = 0; j < 4; ++j) {
                    const float r = sigmoidf_(pr[j] + br4[j]), ig = sigmoidf_(pi[j] + bi4[j]);
                    const float la = -8.f * r * sp4[j];
                    float A = __builtin_amdgcn_exp2f(LOG2E * la), H = __builtin_amdgcn_sqrtf(neg_expm1(2.f * la)) * (ig * x4[j]);
                    { const float Ap = dpp_id1<0x111>(A), Hp = pg8::dppf<0x111>(H); H = A * Hp + H; A = Ap * A; }
                    { const float Ap = dpp_id1<0x112>(A), Hp = pg8::dppf<0x112>(H); H = A * Hp + H; A = Ap * A; }
                    { const float Ap = dpp_id1<0x114>(A), Hp = pg8::dppf<0x114>(H); H = A * Hp + H; A = Ap * A; }
                    { const float Ap = dpp_id1<0x118>(A), Hp = pg8::dppf<0x118>(H); H = A * Hp + H; A = Ap * A; }
                    const float h = A * hc[db][j] + H;
                    hv[j] = h;
                    const int src = ((lane & 48) | 15) << 2;
                    hc[db][j] = __builtin_bit_cast(float, __builtin_amdgcn_ds_bpermute(src, __builtin_bit_cast(int, h)));
                    if (PASS == 1) Ac[db][j] *= __builtin_bit_cast(float, __builtin_amdgcn_ds_bpermute(src, __builtin_bit_cast(int, A)));
                }
                if (PASS == 2) {
                    const size_t row = rowb + fr;
                    const float y0 = gelu_tanh(bf2f(gg[db].x & 0xffffu)) * hv[0], y1 = gelu_tanh(bf2f(gg[db].x >> 16)) * hv[1], y2 = gelu_tanh(bf2f(gg[db].y & 0xffffu)) * hv[2], y3 = gelu_tanh(bf2f(gg[db].y >> 16)) * hv[3];
                    u32x2 w; w.x = pg8::cvt_pk_bf16(y0, y1); w.y = pg8::cvt_pk_bf16(y2, y3);
                    *(u32x2*)(ya + row * DR + n * LB + d0) = w;
                }
            }
        }
        if (PASS == 1 && fr == 0) {
#pragma unroll
            for (int db = 0; db < 6; ++db) { const size_t o = ((size_t)b * NCH + c) * DR + n * LB + 16 * db + 4 * fq; *(f32x4*)(aggA + o) = Ac[db]; *(f32x4*)(aggH + o) = hc[db]; }
        }
    }
}

__device__ __forceinline__ void carry_phase(const Ptrs& q) {
    const int tix_ = opaque_tid(); const int gidx = ((tix_ >> 6) * (int)gridDim.x + (int)blockIdx.x) * 64 + (tix_ & 63);
    if (gidx >= NB * DR) return;
    const int b = gidx / DR, ch = gidx % DR;
    const float* aggA = q.agg + (size_t)b * NCH * DR + ch; const float* aggH = aggA + (size_t)NB * NCH * DR;
    float a[NCH], g[NCH];
#pragma unroll
    for (int cc = 0; cc < NCH; ++cc) { a[cc] = aggA[(size_t)cc * DR]; g[cc] = aggH[(size_t)cc * DR]; }
    float h = 0.f; float* out = q.hin + (size_t)b * NCH * DR + ch;
#pragma unroll
    for (int cc = 0; cc < NCH; ++cc) { out[(size_t)cc * DR] = h; h = a[cc] * h + g[cc]; }
}
constexpr int AT_STRIDE = 72;
constexpr int AT_BUF = 2 * 64 * AT_STRIDE * 2 + 256;
constexpr int AT_MISC = 2 * AT_BUF;
template <bool BAND>
__device__ __forceinline__ void attn_tile(const unsigned char* sb, const bf16x8 (&qf)[2][2], const float (&cq2)[2], float (&mrun)[2], float (&lrun)[2], f32x4 (&o)[2][4],
                                          int i, int j, int wv, int lane, int fr, int fq) {
    const float SC2 = 0.125f * LOG2E;
    const bf16_t* Ks = (const bf16_t*)sb; const bf16_t* Vs = (const bf16_t*)(sb + 64 * AT_STRIDE * 2); const float* Cs = (const float*)(sb + 2 * 64 * AT_STRIDE * 2);
    const bool band = BAND;
    if (!BAND || !(j >= 4 * i && 64 * (j - 4 * i) > 32 * wv + 31)) {
    bf16x8 kf[4][2]; f32x4 cs4[4]; bf16x8 vf[4][2];
#pragma unroll
    for (int kb = 0; kb < 4; ++kb) { kf[kb][0] = *(const bf16x8*)(Ks + (16 * kb + fr) * AT_STRIDE + 8 * fq); kf[kb][1] = *(const bf16x8*)(Ks + (16 * kb + fr) * AT_STRIDE + 32 + 8 * fq); cs4[kb] = *(const f32x4*)(Cs + 16 * kb + 4 * fq); }
    f32x4 s[2][4];
#pragma unroll
    for (int qb = 0; qb < 2; ++qb)
#pragma unroll
        for (int kb = 0; kb < 4; ++kb) {
            f32x4 a = cs4[kb];
            a = __builtin_amdgcn_mfma_f32_16x16x32_bf16(kf[kb][0], qf[qb][0], a, 0, 0, 0);
            a = __builtin_amdgcn_mfma_f32_16x16x32_bf16(kf[kb][1], qf[qb][1], a, 0, 0, 0);
            s[qb][kb] = a;
        }
#pragma unroll
    for (int db = 0; db < 4; ++db)
#pragma unroll
        for (int ks = 0; ks < 2; ++ks) {
            const u32x2 v0 = *(const u32x2*)(Vs + (16 * db + fr) * AT_STRIDE + 32 * ks + 4 * fq), v1 = *(const u32x2*)(Vs + (16 * db + fr) * AT_STRIDE + 32 * ks + 16 + 4 * fq);
            u32x4 w; w.x = v0.x; w.y = v0.y; w.z = v1.x; w.w = v1.y; vf[db][ks] = __builtin_bit_cast(bf16x8, w);
        }
#pragma unroll
    for (int qb = 0; qb < 2; ++qb) {
#pragma unroll
        for (int kb = 0; kb < 4; ++kb) {
            f32x4 a = s[qb][kb];
            if (band) {
                const int pq = 256 * i + 32 * wv + 16 * qb + fr, pk = 64 * j + 16 * kb + 4 * fq;
#pragma unroll
                for (int e = 0; e < 4; ++e) a[e] = (pk + e >= 240 && pk + e <= pq) ? a[e] : -INFINITY;
            }
            s[qb][kb] = a;
        }
        float mx = s[qb][0][0];
#define MX3(a, b, c) __builtin_fmaxf(__builtin_fmaxf((a), (b)), (c))
        mx = MX3(mx, s[qb][0][1], s[qb][0][2]); mx = MX3(mx, s[qb][0][3], s[qb][1][0]); mx = MX3(mx, s[qb][1][1], s[qb][1][2]); mx = MX3(mx, s[qb][1][3], s[qb][2][0]);
        mx = MX3(mx, s[qb][2][1], s[qb][2][2]); mx = MX3(mx, s[qb][2][3], s[qb][3][0]); mx = MX3(mx, s[qb][3][1], s[qb][3][2]); mx = __builtin_fmaxf(mx, s[qb][3][3]);
#undef MX3
        { const auto r16 = __builtin_amdgcn_permlane16_swap(__builtin_bit_cast(unsigned, mx), __builtin_bit_cast(unsigned, mx), false, false);
          mx = __builtin_fmaxf(__builtin_bit_cast(float, r16[0]), __builtin_bit_cast(float, r16[1]));
          const auto r32 = __builtin_amdgcn_permlane32_swap(__builtin_bit_cast(unsigned, mx), __builtin_bit_cast(unsigned, mx), false, false);
          mx = __builtin_fmaxf(__builtin_bit_cast(float, r32[0]), __builtin_bit_cast(float, r32[1])); }
        const float mn = fmaxf(mrun[qb], mx), scl = __builtin_amdgcn_exp2f(mrun[qb] - mn);
        mrun[qb] = mn;
        f32x4 rs4 = (f32x4){0.f, 0.f, 0.f, 0.f};
#pragma unroll
        for (int kb = 0; kb < 4; ++kb) { const f32x4 t = s[qb][kb] - mn; f32x4 pe;
#pragma unroll
            for (int e = 0; e < 4; ++e) pe[e] = __builtin_amdgcn_exp2f(t[e]);
            s[qb][kb] = pe; rs4 = rs4 + pe; }
        const float rs = (rs4[0] + rs4[1]) + (rs4[2] + rs4[3]);
        lrun[qb] = lrun[qb] * scl + rs;
#pragma unroll
        for (int db = 0; db < 4; ++db) o[qb][db] = o[qb][db] * scl;
        bf16x8 pf[2];
#pragma unroll
        for (int ks = 0; ks < 2; ++ks) { const u32x4 w = pg8::pack8(s[qb][2 * ks], s[qb][2 * ks + 1]); pf[ks] = __builtin_bit_cast(bf16x8, w); }
#pragma unroll
        for (int db = 0; db < 4; ++db)
#pragma unroll
            for (int ks = 0; ks < 2; ++ks) o[qb][db] = __builtin_amdgcn_mfma_f32_16x16x32_bf16(vf[db][ks], pf[ks], o[qb][db], 0, 0, 0);
    }
    }
}
__device__ __forceinline__ void attn_phase(const Ptrs& q, const bf16_t* __restrict__ qg, bf16_t* __restrict__ yb, unsigned char* smem, unsigned* queue, bool skel = false) {
    const int tix = opaque_tid(), lane = tix & 63, wv = __builtin_amdgcn_readfirstlane(tix >> 6), fr = lane & 15, fq = lane >> 4;
    const float SC2 = 0.125f * LOG2E;
    volatile int* misc = (volatile int*)(smem + AT_MISC);
    for (;;) {
        __syncthreads();
        if (tix == 0) misc[0] = (int)__hip_atomic_fetch_add(queue, 1u, __ATOMIC_RELAXED, __HIP_MEMORY_SCOPE_AGENT);
        __syncthreads();
        const int u = misc[0];
        if (u >= 9 * NB * NH) break;
        const int i = 8 - u / (NB * NH), bh = u % (NB * NH), b = bh / NH, h = bh % NH;
        const size_t rowb = (size_t)b * LSEQ;
        const float* cbh = q.ct + (size_t)bh * LSEQ;
        bf16x8 qf[2][2]; float cq2[2], mrun[2], lrun[2]; f32x4 o[2][4];
#pragma unroll
        for (int qb = 0; qb < 2; ++qb) {
            const int tq = 256 * i + 32 * wv + 16 * qb + fr - 240, tqc = tq < 0 ? 0 : tq;
            const bf16_t* qp = qg + (rowb + tqc) * 2048 + h * HD + 8 * fq;
            qf[qb][0] = *(const bf16x8*)(qp); qf[qb][1] = *(const bf16x8*)(qp + 32);
            cq2[qb] = cbh[tqc] * LOG2E; mrun[qb] = -INFINITY; lrun[qb] = 0.f;
#pragma unroll
            for (int db = 0; db < 4; ++db) o[qb][db] = (f32x4){0.f, 0.f, 0.f, 0.f};
        }
        const int lr = tix >> 3, lc = tix & 7;
        const int j0 = 3, j1 = 4 * i + 3;
        u32x4 kA, vA, kB, vB, kC, vC; float cA = 0.f, cB = 0.f, cC = 0.f;
#define AT_LOAD(j, KR, VR, CR) do { const int jl_ = (j) < j1 ? (j) : j1; const int tk = 64 * jl_ - 240 + lr, tkc = tk < 0 ? 0 : tk; \
            KR = *(const u32x4*)(q.kb + (rowb + tkc) * D + h * HD + 8 * lc); \
            const int tv = 64 * jl_ - 240 + 8 * lc, tvc = tv < 0 ? 0 : tv; \
            VR = *(const u32x4*)(q.vt + ((size_t)bh * HD + lr) * LSEQ + tvc); \
            { const int tc = 64 * jl_ - 240 + (tix & 63); CR = cbh[tc < 0 ? 0 : tc]; } } while (0)
#define AT_STEP(jj, KR, VR, CR) do { unsigned char* sb = smem + buf * AT_BUF; \
            *(u32x4*)((bf16_t*)sb + lr * AT_STRIDE + 8 * lc) = KR; *(u32x4*)((bf16_t*)(sb + 64 * AT_STRIDE * 2) + lr * AT_STRIDE + 8 * lc) = VR; if (tix < 64) ((float*)(sb + 2 * 64 * AT_STRIDE * 2))[tix] = CR * -LOG2E; \
            __syncthreads(); \
            AT_LOAD((jj) + 3, KR, VR, CR); \
            if (!skel) { if ((jj) == 3 || (jj) >= 4 * i) attn_tile<true>(sb, qf, cq2, mrun, lrun, o, i, (jj), wv, lane, fr, fq); else attn_tile<false>(sb, qf, cq2, mrun, lrun, o, i, (jj), wv, lane, fr, fq); } \
            buf ^= 1; } while (0)
        AT_LOAD(j0, kA, vA, cA); AT_LOAD(j0 + 1, kB, vB, cB); AT_LOAD(j0 + 2, kC, vC, cC);
        int buf = 0;
        for (int j = j0; j <= j1; j += 3) {
            AT_STEP(j, kA, vA, cA);
            if (j + 1 <= j1) AT_STEP(j + 1, kB, vB, cB);
            if (j + 2 <= j1) AT_STEP(j + 2, kC, vC, cC);
        }
#undef AT_STEP
#undef AT_LOAD
#pragma unroll
        for (int qb = 0; qb < 2; ++qb) {
            float l = lrun[qb]; l += shfl_xor_f(l, lane, 16); l += shfl_xor_f(l, lane, 32);
            const float il = __builtin_amdgcn_rcpf(l);
            const int tq = 256 * i + 32 * wv + 16 * qb + fr - 240;
            if (tq >= 0 && !skel) {
                const size_t row = rowb + tq;
#pragma unroll
                for (int db = 0; db < 4; ++db) {
                    const int col = h * HD + 16 * db + 4 * fq;
                    const u32x2 gg = *(const u32x2*)(qg + row * 2048 + D + col);
                    const float y0 = o[qb][db][0] * il * sigmoidf_(bf2f(gg.x & 0xffffu)), y1 = o[qb][db][1] * il * sigmoidf_(bf2f(gg.x >> 16));
                    const float y2 = o[qb][db][2] * il * sigmoidf_(bf2f(gg.y & 0xffffu)), y3 = o[qb][db][3] * il * sigmoidf_(bf2f(gg.y >> 16));
                    u32x2 w; w.x = pk2(y0, y1); w.y = pk2(y2, y3);
                    *(u32x2*)(yb + row * D + col) = w;
                }
            }
        }
    }
}
#ifndef FAST_GEMM
#define FAST_GEMM 1
#endif
#ifdef PROBE_BARRIER
#define PROBE_BAR2 grid_barrier((unsigned*)(p.ws + W_CTL), ++bar_k); grid_barrier((unsigned*)(p.ws + W_CTL), ++bar_k);
#else
#define PROBE_BAR2
#endif
#ifndef FAST_SCAN
#define FAST_SCAN 1
#endif
#ifndef FAST_ATTN
#define FAST_ATTN 1
#endif
#ifndef FAST_FFN1
#define FAST_FFN1 1
#endif
constexpr int LDS_BYTES = 139264;

__device__ __forceinline__ void tail_proj(const bf16_t* __restrict__ A, const bf16_t* __restrict__ Bt, bf16_t* __restrict__ O, int ldo, int nct, int nscaled, float qs) {
    int ct = (int)blockIdx.x; asm volatile("" : "+s"(ct)); if (ct >= nct) return;
    const int tix = opaque_tid(), lane = tix & 63, w = tix >> 6, fr = lane & 15, fq = lane >> 4;
    const bf16_t* ap = A + (size_t)(TAIL0 + 16 * w + fr) * D + 8 * fq;
    const bf16_t* bp = Bt + (size_t)(16 * ct + fr) * D + 8 * fq;
    f32x4 acc = {0.f, 0.f, 0.f, 0.f};
    for (int k0 = 0; k0 < 32; k0 += 8) {
        bf16x8 a[8], b[8];
#pragma unroll
        for (int u = 0; u < 8; ++u) { a[u] = *(const bf16x8*)(ap + (k0 + u) * 32); b[u] = *(const bf16x8*)(bp + (k0 + u) * 32); }
        __builtin_amdgcn_sched_barrier(0);
#pragma unroll
        for (int u = 0; u < 8; ++u) acc = __builtin_amdgcn_mfma_f32_16x16x32_bf16(b[u], a[u], acc, 0, 0, 0);
        __builtin_amdgcn_sched_barrier(0);
    }
    const float sc = ct < nscaled ? qs : 1.f;
    u32x2 o; o.x = pk2(acc[0] * sc, acc[1] * sc); o.y = pk2(acc[2] * sc, acc[3] * sc);
    *(u32x2*)(O + (size_t)(TAIL0 + 16 * w + fr) * ldo + 16 * ct + 4 * fq) = o;
}
template <bool VT> __device__ __forceinline__ void tail_tile(const bf16_t* __restrict__ A, const bf16_t* __restrict__ Bt, bf16_t* __restrict__ O, int ldo, int ct, float sc) {
    const int tix = opaque_tid(), lane = tix & 63, w = tix >> 6, fr = lane & 15, fq = lane >> 4;
    const bf16_t* ap = A + (size_t)(TAIL0 + 16 * w + fr) * D + 8 * fq;
    const bf16_t* bp = Bt + (size_t)(16 * ct + fr) * D + 8 * fq;
    f32x4 acc = {0.f, 0.f, 0.f, 0.f};
    for (int k0 = 0; k0 < 32; k0 += 8) {
        bf16x8 a[8], b[8];
#pragma unroll
        for (int u = 0; u < 8; ++u) { a[u] = *(const bf16x8*)(ap + (k0 + u) * 32); b[u] = *(const bf16x8*)(bp + (k0 + u) * 32); }
        __builtin_amdgcn_sched_barrier(0);
#pragma unroll
        for (int u = 0; u < 8; ++u) acc = VT ? __builtin_amdgcn_mfma_f32_16x16x32_bf16(a[u], b[u], acc, 0, 0, 0)
                                             : __builtin_amdgcn_mfma_f32_16x16x32_bf16(b[u], a[u], acc, 0, 0, 0);
        __builtin_amdgcn_sched_barrier(0);
    }
    u32x2 o; o.x = pk2(acc[0] * sc, acc[1] * sc); o.y = pk2(acc[2] * sc, acc[3] * sc);
    if (VT) { const int f = 16 * ct + fr; *(u32x2*)(O + ((size_t)(7 * NH + (f >> 6)) * HD + (f & 63)) * LSEQ + (TAIL0 - 7 * LSEQ) + 16 * w + 4 * fq) = o; }
    else *(u32x2*)(O + (size_t)(TAIL0 + 16 * w + fr) * ldo + 16 * ct + 4 * fq) = o;
}
__device__ __forceinline__ void tail_kvq(const Ptrs& q, bf16_t* qg) {
    int c0 = (int)blockIdx.x; asm volatile("" : "+s"(c0));
    for (int tile = c0; tile < 256; tile += (int)gridDim.x) {
        if (tile < 64) tail_tile<false>(q.hb, q.bin, qg, 2048, tile, 0.125f * LOG2E);
        else if (tile < 128) tail_tile<false>(q.hb, q.bin, qg, 2048, tile, 1.f);
        else if (tile < 192) tail_tile<false>(q.hb, q.kv, q.kb, D, tile - 128, 1.f);
        else tail_tile<true>(q.hb, q.kv + (size_t)D * D, q.vt, 0, tile - 192, 1.f);
    }
}
__device__ __forceinline__ void grid_barrier(unsigned* ctr, unsigned k) {
    __syncthreads();
    if (opaque_tid() == 0) {
        __builtin_amdgcn_fence(__ATOMIC_RELEASE, "agent");
        const unsigned G = gridDim.x, g = blockIdx.x & 7u, ng = G < 8u ? G : 8u, cnt = (G - g + 7u) >> 3;
        const unsigned old = __hip_atomic_fetch_add(ctr + 64 + 64 * g, 1u, __ATOMIC_RELAXED, __HIP_MEMORY_SCOPE_AGENT);
        if (old == k * cnt - 1u) __hip_atomic_fetch_add(ctr, 1u, __ATOMIC_RELAXED, __HIP_MEMORY_SCOPE_AGENT);
        const unsigned target = k * ng;
        while (__hip_atomic_load(ctr, __ATOMIC_RELAXED, __HIP_MEMORY_SCOPE_AGENT) < target) __builtin_amdgcn_s_sleep(1);
        __builtin_amdgcn_fence(__ATOMIC_ACQUIRE, "agent");
    }
    __syncthreads();
}

typedef const __attribute__((address_space(4))) unsigned char* KARG;
__device__ __forceinline__ Params load_params(KARG pk) {
    const __attribute__((address_space(4))) unsigned long long* k = (const __attribute__((address_space(4))) unsigned long long*)pk;
    Params p;
    p.x = (const float*)(const __attribute__((address_space(1))) float*)k[0];    p.meta = (const float*)(const __attribute__((address_space(1))) float*)k[1];    p.a_w_in = (const float*)(const __attribute__((address_space(1))) float*)k[2];    p.a_conv_w = (const float*)(const __attribute__((address_space(1))) float*)k[3];    p.a_conv_b = (const float*)(const __attribute__((address_space(1))) float*)k[4];    p.a_w_r = (const float*)(const __attribute__((address_space(1))) float*)k[5];    p.a_b_r = (const float*)(const __attribute__((address_space(1))) float*)k[6];    p.a_w_i = (const float*)(const __attribute__((address_space(1))) float*)k[7];    p.a_b_i = (const float*)(const __attribute__((address_space(1))) float*)k[8];    p.a_lambda = (const float*)(const __attribute__((address_space(1))) float*)k[9];    p.a_w_out = (const float*)(const __attribute__((address_space(1))) float*)k[10];    p.kv_w = (const float*)(const __attribute__((address_space(1))) float*)k[11];    p.kv_f_b = (const float*)(const __attribute__((address_space(1))) float*)k[12];    p.b_w_in = (const float*)(const __attribute__((address_space(1))) float*)k[13];    p.b_w_out = (const float*)(const __attribute__((address_space(1))) float*)k[14];    p.f_w_in = (const float*)(const __attribute__((address_space(1))) float*)k[15];    p.f_conv_w = (const float*)(const __attribute__((address_space(1))) float*)k[16];    p.f_conv_b = (const float*)(const __attribute__((address_space(1))) float*)k[17];    p.f_w_out = (const float*)(const __attribute__((address_space(1))) float*)k[18];    p.ln1_g = (const float*)(const __attribute__((address_space(1))) float*)k[19];    p.ln1_b = (const float*)(const __attribute__((address_space(1))) float*)k[20];    p.ln2_g = (const float*)(const __attribute__((address_space(1))) float*)k[21];    p.ln2_b = (const float*)(const __attribute__((address_space(1))) float*)k[22];
    p.out = (float*)(__attribute__((address_space(1))) float*)k[23]; p.ws = (unsigned char*)(__attribute__((address_space(1))) unsigned char*)k[24]; p.ph_lo = 0; p.ph_hi = 0;
    return p;
}
__global__ void __launch_bounds__(512, 2) mega(Params p_in) {
    extern __shared__ __attribute__((aligned(16))) unsigned char smem[];
    LAS unsigned char* lds = (LAS unsigned char*)smem;
    const KARG pk0 = (KARG)__builtin_amdgcn_kernarg_segment_ptr();
    const int G = gridDim.x, bx = blockIdx.x, vcu = (G % 8 == 0) ? (bx % 8) * (G / 8) + bx / 8 : bx;
    const int ph_lo = p_in.ph_lo, ph_hi = p_in.ph_hi;
    int ph = 0; unsigned bar_k = 0;
#define PHASE(...) do { if (ph >= ph_lo && ph < ph_hi) { KARG pk = pk0; asm volatile("" : "+s"(pk)); const Params p = load_params(pk); const Ptrs q = make_ptrs(p); \
        bf16_t* const gr = q.big + (size_t)PADR * 3072; bf16_t* const ya = q.yb + (size_t)PADR * DR; bf16_t* const qg = q.big + (size_t)PADR * 2048; bf16_t* const yb = q.yb + (size_t)PADR * D; bf16_t* const g = q.big + (size_t)PADR * DFF; bf16_t* const mixm = q.big + (size_t)PADR * D; bf16_t* const mixf = q.yb + (size_t)PADR * D; bf16_t* const mixm2 = q.big + (size_t)(ROWS + PADR) * D; bf16_t* const mixf2 = q.hb; (void)mixm; (void)mixf; (void)mixm2; (void)mixf2; \
        (void)gr; (void)ya; (void)qg; (void)yb; (void)g; \
        __VA_ARGS__; \
        if (ph + 1 < ph_hi) { if (ph == 0) cg::this_grid().sync(); else { grid_barrier((unsigned*)(p.ws + W_CTL), ++bar_k); PROBE_BAR2 } } } ++ph; } while (0)
#define PHASE_PRE(...) do { if (ph >= ph_lo && ph < ph_hi) { KARG pk = pk0; asm volatile("" : "+s"(pk)); const Params p = load_params(pk); const Ptrs q = make_ptrs(p); \
        bf16_t* const gr = q.big + (size_t)PADR * 3072; bf16_t* const qg = q.big + (size_t)PADR * 2048; (void)gr; (void)qg; (void)p; \
        __VA_ARGS__; } } while (0)
    PHASE(prologue(p, q, (float*)smem));
#if defined(PROBE_DUP) || defined(PROBE_PRO)
    PHASE(prologue(p, q, (float*)smem));
#endif
    for (int layer = 0; layer < 4; ++layer) {
        if (layer < 2) {
            PHASE_PRE(tail_proj(q.hb, q.ain + (size_t)layer * 3072 * D, gr, 3072, 192, 0, 1.f));
            PHASE({ pg8::Sched<false> S{}; S.j0 = pg8::Job{q.hb, q.ain + (size_t)layer * 3072 * D, 64, 3072 / 256, 0, 0}; S.nj = 1; S.K = D; S.G = G; S.c = bx; S.ld = S.K;
                    pg8::EpiStore E{gr, nullptr, nullptr, 3072, 0}; pg8::gemm_phase<pg8::EpiStore, false>(lds, S, E); });
#if defined(PROBE_DUP2) || defined(PROBE_A1)
            PHASE({ pg8::Sched<false> S{}; S.j0 = pg8::Job{q.hb, q.ain + (size_t)layer * 3072 * D, MP / 256, 3072 / 256, 0, 0}; S.nj = 1; S.K = D; S.G = G; S.c = bx; S.ld = S.K;
                    pg8::EpiStore E{gr, nullptr, nullptr, 3072, 0}; pg8::gemm_phase<pg8::EpiStore, false>(lds, S, E); });
#endif
#if FAST_SCAN
            PHASE(scan_phase<1>(p, q, layer, smem));
            PHASE(carry_phase(q));
            PHASE(scan_phase<2>(p, q, layer, smem));
#if defined(PROBE_DUP) || defined(PROBE_SCAN)
            PHASE(scan_phase<1>(p, q, layer, smem));
            PHASE(scan_phase<2>(p, q, layer, smem));
#endif
#else
            PHASE(rglru_simple(gr, p.a_conv_w + (size_t)layer * 4 * DR, p.a_conv_b + (size_t)layer * DR, p.a_w_r + (size_t)layer * NLB * LB * LB, p.a_b_r + (size_t)layer * DR,
                               p.a_w_i + (size_t)layer * NLB * LB * LB, p.a_b_i + (size_t)layer * DR, p.a_lambda + (size_t)layer * DR, ya, (float*)smem));
#endif
            PHASE({ pg8::Sched<false> S{}; S.j0 = pg8::Job{ya, q.aout + (size_t)layer * D * DR, 64, D / 256, 0, 0}; S.j1 = pg8::Job{ya + (size_t)TAIL0 * DR, q.aout + (size_t)layer * D * DR, DR / 256, D / 256, 2, 256};
                    S.nj = 2; S.K = DR; S.G = G; S.c = bx; S.ld = DR;
                    pg8::EpiStore E{mixm, nullptr, q.part, D, D}; pg8::gemm_phase<pg8::EpiStore, false>(lds, S, E); });
        } else {
            const int j = layer - 2;
            if (j == 0) PHASE_PRE(tail_kvq(q, qg));
            if (j == 0) PHASE({ pg8::Sched<false> S{}; S.j0 = pg8::Job{q.hb, q.bin, 64, 8, 2, 0}; S.j1 = pg8::Job{q.hb, q.kv, 64, 4, 0, 0}; S.j2 = pg8::Job{q.kv + (size_t)D * D, q.hb, 4, 64, 1, 0};
                    S.nj = 3; S.K = D; S.G = G; S.c = bx; S.ld = S.K;
                    pg8::EpiStore E{q.kb, q.vt, qg, D, 2048, 0.125f * LOG2E}; pg8::gemm_phase<pg8::EpiStore, false>(lds, S, E);
                    cumsum_wave(q.logf, q.ct); });
            if (j != 0) PHASE_PRE(tail_proj(q.hb, q.bin + (size_t)2048 * D, qg, 2048, 128, 64, 0.125f * LOG2E));
            if (j != 0) PHASE({ pg8::Sched<false> S{}; S.j0 = pg8::Job{q.hb, q.bin + (size_t)2048 * D, 64, 8, 2, 0}; S.nj = 1; S.K = D; S.G = G; S.c = bx; S.ld = S.K;
                    pg8::EpiStore E{q.kb, q.vt, qg, D, 2048, 0.125f * LOG2E}; pg8::gemm_phase<pg8::EpiStore, false>(lds, S, E); });
#ifdef PROBE_DUP2
            if (j == 0) PHASE({ pg8::Sched<false> S{}; S.j0 = pg8::Job{q.hb, q.bin, MP / 256, 8, 2, 0}; S.j1 = pg8::Job{q.hb, q.kv, MP / 256, 4, 0, 0}; S.j2 = pg8::Job{q.kv + (size_t)D * D, q.hb, 4, MP / 256, 1, 0};
                    S.nj = 3; S.K = D; S.G = G; S.c = bx; S.ld = S.K;
                    pg8::EpiStore E{q.kb, q.vt, qg, D, 2048, 0.125f * LOG2E}; pg8::gemm_phase<pg8::EpiStore, false>(lds, S, E);
                    cumsum_wave(q.logf, q.ct); });
            else PHASE({ pg8::Sched<false> S{}; S.j0 = pg8::Job{q.hb, q.bin + (size_t)2048 * D, MP / 256, 8, 2, 0}; S.nj = 1; S.K = D; S.G = G; S.c = bx; S.ld = S.K;
                    pg8::EpiStore E{q.kb, q.vt, qg, D, 2048, 0.125f * LOG2E}; pg8::gemm_phase<pg8::EpiStore, false>(lds, S, E); });
#endif
#if defined(ATTN_NOLDS)
            PHASE(attn_phase2(q, qg, yb, smem, (unsigned*)(p.ws + W_CTL) + 16 + 16 * j));
#elif FAST_ATTN
            PHASE(attn_phase(q, qg, yb, smem, (unsigned*)(p.ws + W_CTL) + 16 + 16 * j));
#if defined(PROBE_DUP) || defined(PROBE_DUP_ATTN)
            PHASE(attn_phase(q, qg, yb, smem, (unsigned*)(p.ws + W_CTL) + 24 + 16 * j));
#endif
#if defined(PROBE_ATTN_SKEL)
            PHASE(attn_phase(q, qg, yb, smem, (unsigned*)(p.ws + W_CTL) + 24 + 16 * j, true));
#endif
#else
            PHASE(attn_simple(qg, q.kb, q.vt, q.ct, yb));
#endif
            PHASE({ pg8::Sched<false> S{}; S.j0 = pg8::Job{yb, q.bout + (size_t)j * D * D, 64, D / 256, 0, 0}; S.j1 = pg8::Job{yb + (size_t)TAIL0 * D, q.bout + (size_t)j * D * D, D / 256, D / 256, 2, 256};
                    S.nj = 2; S.K = D; S.G = G; S.c = bx; S.ld = D;
                    pg8::EpiStore E{mixm, nullptr, q.part, D, D}; pg8::gemm_phase<pg8::EpiStore, false>(lds, S, E); });
        }
        PHASE(ln_phase(p, q, q.hb, layer == 3 ? q.kb : (bf16_t*)nullptr, mixm, layer < 2 ? DR / 256 : D / 256, p.ln1_g + (size_t)layer * D, p.ln1_b + (size_t)layer * D, 0));
        PHASE({ pg8::Sched<true> S{}; S.j0 = pg8::Job{q.hb, q.fin + (size_t)layer * 5632 * D, 66, 22, 0, 0}; S.nj = 1; S.K = D; S.G = G; S.c = bx; S.ld = S.K;
                pg8::EpiFfn1 E{g, p.f_conv_w + (size_t)layer * 3 * 5632, p.f_conv_b + (size_t)layer * 5632, (LAS float*)(lds + pg8::STAGE_BYTES)}; pg8::gemm_phase<pg8::EpiFfn1, true>(lds, S, E); });
#if defined(PROBE_DUP2) || defined(PROBE_F1)
        PHASE({ pg8::Sched<true> S{}; S.j0 = pg8::Job{q.hb, q.fin + (size_t)layer * 5632 * D, 66, 22, 0, 0}; S.nj = 1; S.K = D; S.G = G; S.c = bx; S.ld = S.K;
                pg8::EpiFfn1 E{g, p.f_conv_w + (size_t)layer * 3 * 5632, p.f_conv_b + (size_t)layer * 5632, (LAS float*)(lds + pg8::STAGE_BYTES)}; pg8::gemm_phase<pg8::EpiFfn1, true>(lds, S, E); });
#endif
        PHASE({ pg8::Sched<false> S{}; S.j0 = pg8::Job{g, q.wfout + (size_t)layer * D * DFF, 64, D / 256, 0, 0}; S.j1 = pg8::Job{g + (size_t)TAIL0 * DFF, q.wfout + (size_t)layer * D * DFF, DFF / 256, D / 256, 2, 256};
                S.nj = 2; S.K = DFF; S.G = G; S.c = bx; S.ld = DFF;
                pg8::EpiStore E{mixf, nullptr, q.part, D, D}; pg8::gemm_phase<pg8::EpiStore, false>(lds, S, E); });
        PHASE(ln_phase(p, q, layer == 3 ? (const bf16_t*)q.kb : (const bf16_t*)q.hb, (bf16_t*)nullptr, mixf, DFF / 256, p.ln2_g + (size_t)layer * D, p.ln2_b + (size_t)layer * D, layer == 3 ? 2 : (layer == 1 ? 1 : 0)));
    }
#undef PHASE
}

extern "C" void kernel_launch(void* const* d_in, const int* in_sizes, int n_in, void* d_out, int out_size, void* d_ws, size_t ws_size, hipStream_t stream) {
    static int grid = 0;
    if (grid == 0) {
        int dev = 0, cus = 0, per_cu = 0;
        hipGetDevice(&dev); hipDeviceGetAttribute(&cus, hipDeviceAttributeMultiprocessorCount, dev);
        hipFuncSetAttribute((const void*)mega, hipFuncAttributeMaxDynamicSharedMemorySize, LDS_BYTES);
        hipOccupancyMaxActiveBlocksPerMultiprocessor(&per_cu, (const void*)mega, 512, LDS_BYTES);
        if (per_cu < 1) { fprintf(stderr, "kernel_launch: occupancy query says %d blocks/CU\n", per_cu); per_cu = 1; }
        grid = cus * per_cu;
        if (ws_size < W_END) fprintf(stderr, "kernel_launch: ws_size %zu < %zu\n", ws_size, (size_t)W_END);
    }
    hipMemsetAsync((unsigned char*)d_ws + W_CTL, 0, 4096, stream);
    Params p{};
    const float** f = (const float**)&p.x;
    for (int i = 0; i < 23; ++i) f[i] = (const float*)d_in[i];
    p.out = (float*)d_out; p.ws = (unsigned char*)d_ws; p.ph_lo = 0; p.ph_hi = 1000;
    void* args[] = {&p};
    hipError_t e = hipLaunchCooperativeKernel((const void*)mega, dim3(grid), dim3(512), args, LDS_BYTES, stream);
    if (e != hipSuccess) fprintf(stderr, "cooperative launch failed: %s (grid %d)\n", hipGetErrorString(e), grid);
}
```

```cpp
#include <hip/hip_runtime.h>
#include <hip/hip_cooperative_groups.h>
#include <cstdint>
#include <cstdio>
namespace cg = cooperative_groups;

typedef unsigned short bf16_t;
typedef short bf16x8 __attribute__((ext_vector_type(8)));
typedef float f32x4 __attribute__((ext_vector_type(4)));
typedef unsigned u32x4 __attribute__((ext_vector_type(4)));
typedef unsigned u32x2 __attribute__((ext_vector_type(2)));

constexpr int NB = 8, LSEQ = 2064, NMETA = 16, SEQ = 2048, M = NB * LSEQ  , MP = 16640, PADR = 16;
constexpr int D = 1024, DR = 1536, DFF = 2816, NH = 16, HD = 64, NLB = 16, LB = 96;
constexpr int NCH = 43, TCH = 48;
constexpr float ALPHA = 1.6817928305074290f;
constexpr float LN_EPS = 1e-5f;
constexpr float LOG2E = 1.4426950408889634f;

constexpr size_t ROWS = MP + PADR;
constexpr size_t O_HB = 0;
constexpr size_t O_WFOUT = O_HB + ROWS * D * 2;
constexpr size_t O_WRI = O_WFOUT + (size_t)4 * D * DFF * 2;
constexpr size_t O_AGG = O_WRI + (size_t)2 * 2 * NLB * LB * LB * 2;
constexpr size_t O_LOGF = O_AGG + (size_t)2 * NB * NCH * DR * 4;
constexpr size_t O_CT = O_LOGF + (size_t)NB * NH * LSEQ * 4;
constexpr size_t O_HIN = O_CT + (size_t)NB * NH * LSEQ * 4;
constexpr size_t O_END = O_HIN + (size_t)NB * NCH * DR * 4;
static_assert(O_END <= (size_t)NB * SEQ * D * 4, "d_out scratch map");
constexpr size_t W_CTL = 0;
constexpr size_t W_AIN = 4096;
constexpr size_t W_AOUT = W_AIN + (size_t)2 * 3072 * 1024 * 2;
constexpr size_t W_KV = W_AOUT + (size_t)2 * 1024 * 1536 * 2;
constexpr size_t W_BIN = W_KV + (size_t)2048 * 1024 * 2;
constexpr size_t W_BOUT = W_BIN + (size_t)2 * 2048 * 1024 * 2;
constexpr size_t W_FIN = W_BOUT + (size_t)2 * 1024 * 1024 * 2;
constexpr size_t W_HF = W_FIN + (size_t)4 * 5632 * 1024 * 2;
constexpr size_t W_BIG = W_HF + ROWS * D * 4;
constexpr size_t W_YB = W_BIG + ROWS * 3072 * 2;
constexpr size_t W_K = W_YB + ROWS * 1024 * 2;
constexpr size_t W_VT = W_K + ROWS * 1024 * 2;
constexpr size_t W_PART = W_VT + (size_t)NB * NH * HD * LSEQ * 2;
constexpr size_t W_END = W_PART + (size_t)11 * 256 * D * 2;
static_assert(W_END <= (size_t)369098752, "d_ws map must fit 4 x largest input");
static_assert(W_YB + ROWS * DR * 2 <= W_END, "A-layer y fits");

struct Params {
    const float *x, *meta, *a_w_in, *a_conv_w, *a_conv_b, *a_w_r, *a_b_r, *a_w_i, *a_b_i, *a_lambda, *a_w_out, *kv_w, *kv_f_b, *b_w_in, *b_w_out,
        *f_w_in, *f_conv_w, *f_conv_b, *f_w_out, *ln1_g, *ln1_b, *ln2_g, *ln2_b;
    float* out; unsigned char* ws;
    int ph_lo, ph_hi;
};

__device__ __forceinline__ unsigned f2bf(float f) { unsigned u = __builtin_bit_cast(unsigned, f); return (u + 0x7fffu + ((u >> 16) & 1u)) >> 16; }
__device__ __forceinline__ float bf2f(unsigned b) { return __builtin_bit_cast(float, b << 16); }
__device__ __forceinline__ unsigned pk2(float lo, float hi) { return f2bf(lo) | (f2bf(hi) << 16); }
__device__ __forceinline__ float sigmoidf_(float x) { return __builtin_amdgcn_rcpf(1.f + __builtin_amdgcn_exp2f(-LOG2E * x)); }
__device__ __forceinline__ float gelu_tanh(float x) { const float u = 0.7978845608028654f * (x + 0.044715f * x * x * x); return x * __builtin_amdgcn_rcpf(1.f + __builtin_amdgcn_exp2f((-2.f * LOG2E) * u)); }
__device__ __forceinline__ float log1p_pos(float x) { return x < 0.1f ? x * (1.f - x * (0.5f - x * (0.33333333f - x * 0.25f))) : __logf(1.f + x); }
__device__ __forceinline__ float neg_expm1(float y) { return y > -0.25f ? -y * (1.f + y * (0.5f + y * (0.16666667f + y * (0.041666667f + y * 0.0083333333f)))) : 1.f - __expf(y); }
__device__ __forceinline__ float shfl_xor_f(float v, int lane, int o) { return __builtin_bit_cast(float, __builtin_amdgcn_ds_bpermute((lane ^ o) << 2, __builtin_bit_cast(int, v))); }
__device__ __forceinline__ float wave_sum(float v, int lane) {
#pragma unroll
    for (int o = 32; o > 0; o >>= 1) v += shfl_xor_f(v, lane, o);
    return v;
}
__device__ __forceinline__ int opaque_tid() { int t = threadIdx.x; asm volatile("" : "+v"(t)); return t; }

struct Ptrs {
    bf16_t *hb, *wfout, *wri, *ain, *aout, *kv, *bin, *bout, *fin, *big, *yb, *kb, *vt, *part;
    float *agg, *logf, *ct, *hf, *hin; bf16_t* hlo;
};
__device__ __host__ __forceinline__ Ptrs make_ptrs(const Params& p) {
    Ptrs q; unsigned char* o = (unsigned char*)p.out; unsigned char* w = p.ws;
    q.hb = (bf16_t*)(o + O_HB) + (size_t)PADR * D; q.wfout = (bf16_t*)(o + O_WFOUT); q.wri = (bf16_t*)(o + O_WRI);
    q.agg = (float*)(o + O_AGG); q.hin = (float*)(o + O_HIN); q.logf = (float*)(o + O_LOGF); q.ct = (float*)(o + O_CT);
    q.ain = (bf16_t*)(w + W_AIN); q.aout = (bf16_t*)(w + W_AOUT); q.kv = (bf16_t*)(w + W_KV); q.bin = (bf16_t*)(w + W_BIN); q.bout = (bf16_t*)(w + W_BOUT); q.fin = (bf16_t*)(w + W_FIN);
    q.hf = (float*)(w + W_HF) + (size_t)PADR * D; q.hlo = (bf16_t*)(w + W_HF) + (size_t)PADR * D;
    q.big = (bf16_t*)(w + W_BIG);
    q.yb = (bf16_t*)(w + W_YB);
    q.kb = (bf16_t*)(w + W_K) + (size_t)PADR * D; q.vt = (bf16_t*)(w + W_VT); q.part = (bf16_t*)(w + W_PART);
    return q;
}

__device__ __forceinline__ int rowmap(int n, int mode) {
    if (mode == 0) return n;
    const int bj = n / DFF, jj = n % DFF; return (jj >> 7) * 256 + bj * 128 + (jj & 127);
}
__device__ __forceinline__ void transpose_convert(const float* __restrict__ W, int K, int N, int ldw, bf16_t* __restrict__ Wt, int mode, float* slab, int nwaves, int gwave, int lane) {
    const int tn = N / 64, nt = (K / 64) * tn;
    for (int t = gwave; t < nt; t += nwaves) {
        const int k0 = (t / tn) * 64, n0 = (t % tn) * 64;
        f32x4 v[16];
#pragma unroll
        for (int r4 = 0; r4 < 16; ++r4) v[r4] = *(const f32x4*)(W + (size_t)(k0 + r4 * 4 + (lane >> 4)) * ldw + n0 + (lane & 15) * 4);
#pragma unroll
        for (int r4 = 0; r4 < 16; ++r4)
#pragma unroll
            for (int e = 0; e < 4; ++e) slab[((lane & 15) * 4 + e) * 65 + r4 * 4 + (lane >> 4)] = v[r4][e];
#pragma unroll 4
        for (int i = 0; i < 32; ++i) { const int n = i * 2 + (lane >> 5), kp = lane & 31;
            const float a = slab[n * 65 + 2 * kp], c = slab[n * 65 + 2 * kp + 1];
            *(unsigned*)(Wt + (size_t)rowmap(n0 + n, mode) * K + k0 + 2 * kp) = pk2(a, c); }
    }
}
struct WMat { const float* W; bf16_t* Wt; int K, N, ldw, mode; };
__device__ __forceinline__ WMat wmat(const Params& p, const Ptrs& q, int m) {
    WMat r;
    if (m < 2)       { r.W = p.a_w_in + (size_t)m * D * 3072; r.Wt = q.ain + (size_t)m * 3072 * D; r.K = D; r.N = 3072; r.ldw = 3072; r.mode = 0; }
    else if (m < 4)  { const int l = m - 2; r.W = p.a_w_out + (size_t)l * DR * D; r.Wt = q.aout + (size_t)l * D * DR; r.K = DR; r.N = D; r.ldw = D; r.mode = 0; }
    else if (m < 6)  { const int l = m - 4; r.W = p.b_w_in + (size_t)l * D * 2048; r.Wt = q.bin + (size_t)l * 2048 * D; r.K = D; r.N = 2048; r.ldw = 2048; r.mode = 0; }
    else if (m < 8)  { const int l = m - 6; r.W = p.b_w_out + (size_t)l * D * D; r.Wt = q.bout + (size_t)l * D * D; r.K = D; r.N = D; r.ldw = D; r.mode = 0; }
    else if (m == 8) { r.W = p.kv_w; r.Wt = q.kv; r.K = D; r.N = 2048; r.ldw = 2064; r.mode = 0; }
    else if (m < 13) { const int l = m - 9; r.W = p.f_w_in + (size_t)l * D * 5632; r.Wt = q.fin + (size_t)l * 5632 * D; r.K = D; r.N = 5632; r.ldw = 5632; r.mode = 1; }
    else             { const int l = m - 13; r.W = p.f_w_out + (size_t)l * DFF * D; r.Wt = q.wfout + (size_t)l * D * DFF; r.K = DFF; r.N = D; r.ldw = D; r.mode = 0; }
    return r;
}
__device__ __forceinline__ int wmat_tiles(int m) { return m < 2 ? 768 : m < 4 ? 384 : m < 6 ? 512 : m < 8 ? 256 : m == 8 ? 512 : m < 13 ? 1408 : 704; }
__device__ __forceinline__ void prologue(const Params& p, const Ptrs& q, float* tile0) {
    const int gsz = gridDim.x, gid = blockIdx.x; const int tix_ = opaque_tid(), lane_ = tix_ & 63, wpb_ = blockDim.x >> 6;
    float* slab = tile0 + (tix_ >> 6) * (64 * 65);
    { const int nwaves = gsz * wpb_, gwave = (tix_ >> 6) * gsz + gid, total = 12800;
      f32x4 vn[16]; WMat cn{}; int k0n = 0, n0n = 0;
#define PRO_FETCH(ft) do { int m_ = 0, t_ = (ft); for (; m_ < 16; ++m_) { const int c_ = wmat_tiles(m_); if (t_ < c_) break; t_ -= c_; } cn = wmat(p, q, m_); const int tn_ = cn.N / 64; k0n = (t_ / tn_) * 64; n0n = (t_ % tn_) * 64; \
          _Pragma("unroll") for (int r4 = 0; r4 < 16; ++r4) vn[r4] = *(const f32x4*)(cn.W + (size_t)(k0n + r4 * 4 + (lane_ >> 4)) * cn.ldw + n0n + (lane_ & 15) * 4); } while (0)
      if (gwave < total) PRO_FETCH(gwave);
      for (int ft = gwave; ft < total; ft += nwaves) {
          f32x4 v[16];
#pragma unroll
          for (int r4 = 0; r4 < 16; ++r4) v[r4] = vn[r4];
          const WMat c = cn; const int k0 = k0n, n0 = n0n;
          if (ft + nwaves < total) PRO_FETCH(ft + nwaves);
#pragma unroll
          for (int r4 = 0; r4 < 16; ++r4)
#pragma unroll
              for (int e = 0; e < 4; ++e) slab[((lane_ & 15) * 4 + e) * 65 + r4 * 4 + (lane_ >> 4)] = v[r4][e];
#pragma unroll 4
          for (int i = 0; i < 32; ++i) { const int n = i * 2 + (lane_ >> 5), kp = lane_ & 31;
              const float a = slab[n * 65 + 2 * kp], cc = slab[n * 65 + 2 * kp + 1];
              *(unsigned*)(c.Wt + (size_t)rowmap(n0 + n, c.mode) * c.K + k0 + 2 * kp) = pk2(a, cc); }
      }
#undef PRO_FETCH
    }
    const size_t gt = (size_t)gid * blockDim.x + opaque_tid(), gn = (size_t)gsz * blockDim.x;
    const float* const wr_src = p.a_w_r; const float* const wi_src = p.a_w_i;
    { const size_t nwri = (size_t)2 * 2 * NLB * LB * LB;
      for (size_t i0 = gt; i0 < nwri; i0 += 5 * gn) {
          float wv_[5];
#pragma unroll
          for (int u = 0; u < 5; ++u) { const size_t ii = i0 + (size_t)u * gn; const size_t i = ii < nwri ? ii : nwri - 1;
              const int c = (int)(i % LB), d = (int)((i / LB) % LB); const size_t ln = (i / (LB * LB)) % (2 * NLB); const int gate = (int)(i / ((size_t)2 * NLB * LB * LB));
              const float* src = gate ? wi_src : wr_src;
              wv_[u] = src[(ln * LB + c) * LB + d]; }
#pragma unroll
          for (int u = 0; u < 5; ++u) { const size_t ii = i0 + (size_t)u * gn; if (ii < nwri) q.wri[ii] = (bf16_t)f2bf(wv_[u]); }
      } }
    { const size_t n4 = (size_t)M * (D / 4);
      for (size_t i0 = gt; i0 < n4; i0 += 8 * gn) {
          f32x4 v[8];
#pragma unroll
          for (int u = 0; u < 8; ++u) { const size_t i = i0 + (size_t)u * gn; const size_t ic = i < n4 ? i : n4 - 1;
              const int row = (int)(ic / (D / 4)), c4 = (int)(ic % (D / 4)) * 4, b = row / LSEQ, t = row % LSEQ;
              v[u] = (t < NMETA) ? *(const f32x4*)(p.meta + (size_t)t * D + c4) : *(const f32x4*)(p.x + ((size_t)b * SEQ + (t - NMETA)) * D + c4); }
#pragma unroll
          for (int u = 0; u < 8; ++u) { const size_t i = i0 + (size_t)u * gn;
              if (i < n4) { const int row = (int)(i / (D / 4)), c4 = (int)(i % (D / 4)) * 4;
                  u32x2 w; w.x = pk2(v[u][0], v[u][1]); w.y = pk2(v[u][2], v[u][3]); *(u32x2*)(q.hb + (size_t)row * D + c4) = w;
                  u32x2 wl; wl.x = pk2(v[u][0] - bf2f(w.x & 0xffffu), v[u][1] - bf2f(w.x >> 16)); wl.y = pk2(v[u][2] - bf2f(w.y & 0xffffu), v[u][3] - bf2f(w.y >> 16)); *(u32x2*)(q.hlo + (size_t)row * D + c4) = wl; } }
      }
    }
}

constexpr int TAIL0 = 16384;
__device__ __forceinline__ void ln_phase(const Params& p, const Ptrs& q, const bf16_t* hsrc, bf16_t* hdup, const bf16_t* __restrict__ mix, int R, const float* g, const float* be, int mode) {
    const int tix = opaque_tid(), lane = tix & 63, wpb = blockDim.x >> 6, gw = (tix >> 6) * gridDim.x + blockIdx.x, nw = gridDim.x * wpb;
    u32x2 hhn[4], hln[4]; u32x2 mn[4], m2n[4];
#define LN_LOAD(r) do { _Pragma("unroll") for (int i = 0; i < 4; ++i) { const size_t o_ = (size_t)(r) * D + i * 256 + lane * 4; hhn[i] = *(const u32x2*)(hsrc + o_); hln[i] = *(const u32x2*)(q.hlo + o_); mn[i] = (r) < TAIL0 ? *(const u32x2*)(mix + o_) : *(const u32x2*)(q.part + o_ - (size_t)TAIL0 * D); m2n[i] = (u32x2){0u, 0u}; } } while (0)
    if (gw < M) LN_LOAD(gw);
    for (int row = gw; row < M; row += nw) {
        f32x4 v[4]; float s = 0.f, s2 = 0.f;
#pragma unroll
        for (int i = 0; i < 4; ++i) { const u32x2 mm = mn[i], m2 = m2n[i];
            const f32x4 hcur = (f32x4){bf2f(hhn[i].x & 0xffffu), bf2f(hhn[i].x >> 16), bf2f(hhn[i].y & 0xffffu), bf2f(hhn[i].y >> 16)} + (f32x4){bf2f(hln[i].x & 0xffffu), bf2f(hln[i].x >> 16), bf2f(hln[i].y & 0xffffu), bf2f(hln[i].y >> 16)};
            v[i] = hcur * ALPHA + ((f32x4){bf2f(mm.x & 0xffffu), bf2f(mm.x >> 16), bf2f(mm.y & 0xffffu), bf2f(mm.y >> 16)} + (f32x4){bf2f(m2.x & 0xffffu), bf2f(m2.x >> 16), bf2f(m2.y & 0xffffu), bf2f(m2.y >> 16)});
            s += v[i][0] + v[i][1] + v[i][2] + v[i][3]; s2 += v[i][0] * v[i][0] + v[i][1] * v[i][1] + v[i][2] * v[i][2] + v[i][3] * v[i][3]; }
        if (row >= TAIL0) {
            if (R == 11) {
#pragma unroll
            for (int r = 1; r < 11; ++r)
#pragma unroll
                for (int i = 0; i < 4; ++i) { const u32x2 mm = *(const u32x2*)(q.part + ((size_t)r * 256 + (row - TAIL0)) * D + i * 256 + lane * 4);
                    const f32x4 a = (f32x4){bf2f(mm.x & 0xffffu), bf2f(mm.x >> 16), bf2f(mm.y & 0xffffu), bf2f(mm.y >> 16)}; v[i] = v[i] + a; }
            } else {
#pragma unroll 5
            for (int r = 1; r < R; ++r)
#pragma unroll
                for (int i = 0; i < 4; ++i) { const u32x2 mm = *(const u32x2*)(q.part + ((size_t)r * 256 + (row - TAIL0)) * D + i * 256 + lane * 4);
                    const f32x4 a = (f32x4){bf2f(mm.x & 0xffffu), bf2f(mm.x >> 16), bf2f(mm.y & 0xffffu), bf2f(mm.y >> 16)}; v[i] = v[i] + a; }
            }
            s = 0.f; s2 = 0.f;
#pragma unroll
            for (int i = 0; i < 4; ++i) { s += v[i][0] + v[i][1] + v[i][2] + v[i][3]; s2 += v[i][0] * v[i][0] + v[i][1] * v[i][1] + v[i][2] * v[i][2] + v[i][3] * v[i][3]; }
        }
        if (row + nw < M) LN_LOAD(row + nw);
#pragma unroll
        for (int o = 32; o > 0; o >>= 1) { const float t1 = shfl_xor_f(s, lane, o), t2 = shfl_xor_f(s2, lane, o); s += t1; s2 += t2; }
        const float mu = s * (1.f / D), var = fmaxf(s2 * (1.f / D) - mu * mu, 0.f);
        const float rstd = rsqrtf(var + LN_EPS);
        const int b = row / LSEQ, t = row % LSEQ;
#pragma unroll
        for (int i = 0; i < 4; ++i) {
            const int c = i * 256 + lane * 4;
            const f32x4 gg = *(const f32x4*)(g + c), bb = *(const f32x4*)(be + c);
            v[i] = (v[i] - mu) * rstd * gg + bb;
            if (mode == 2) { if (t >= NMETA) *(f32x4*)(p.out + ((size_t)b * SEQ + (t - NMETA)) * D + c) = v[i]; }
            else { u32x2 w; w.x = pk2(v[i][0], v[i][1]); w.y = pk2(v[i][2], v[i][3]); *(u32x2*)(q.hb + (size_t)row * D + c) = w; if (hdup) *(u32x2*)(hdup + (size_t)row * D + c) = w;
                   u32x2 wl; wl.x = pk2(v[i][0] - bf2f(w.x & 0xffffu), v[i][1] - bf2f(w.x >> 16)); wl.y = pk2(v[i][2] - bf2f(w.y & 0xffffu), v[i][3] - bf2f(w.y >> 16)); *(u32x2*)(q.hlo + (size_t)row * D + c) = wl; }
        }
        if (mode == 1) {
            float acc[NH];
#pragma unroll
            for (int h = 0; h < NH; ++h) acc[h] = 0.f;
#pragma unroll 4
            for (int k = 0; k < 16; ++k) {
                    const int cidx = (k >> 2) * 256 + lane * 4 + (k & 3);
                    const float* wr = p.kv_w + (size_t)cidx * 2064 + 2048;
                    const f32x4 w0 = *(const f32x4*)(wr), w1 = *(const f32x4*)(wr + 4), w2 = *(const f32x4*)(wr + 8), w3 = *(const f32x4*)(wr + 12);
                    const float hv = bf2f(q.hb[(size_t)row * D + cidx]) + bf2f(q.hlo[(size_t)row * D + cidx]);
                    acc[0] += hv * w0[0]; acc[1] += hv * w0[1]; acc[2] += hv * w0[2]; acc[3] += hv * w0[3];
                    acc[4] += hv * w1[0]; acc[5] += hv * w1[1]; acc[6] += hv * w1[2]; acc[7] += hv * w1[3];
                    acc[8] += hv * w2[0]; acc[9] += hv * w2[1]; acc[10] += hv * w2[2]; acc[11] += hv * w2[3];
                    acc[12] += hv * w3[0]; acc[13] += hv * w3[1]; acc[14] += hv * w3[2]; acc[15] += hv * w3[3];
                }
#pragma unroll
            for (int h = 0; h < NH; ++h) {
                const float z = wave_sum(acc[h], lane) + p.kv_f_b[h];
                const float lf = fminf(z, 0.f) - log1p_pos(__expf(-fabsf(z)));
                if (lane == 0) q.logf[((size_t)b * NH + h) * LSEQ + t] = lf;
            }
        }
    }
}
#undef LN_LOAD

template <class Epi>
__device__ __forceinline__ void gemm_simple(const bf16_t* __restrict__ A, int lda, const bf16_t* __restrict__ Bt, int ldb, int Mrows, int N, int K, Epi epi) {
    const int tix = opaque_tid(), lane = tix & 63, fr = lane & 15, fq = lane >> 4;
    const int gw = (blockIdx.x * blockDim.x + tix) >> 6, nw = (gridDim.x * blockDim.x) >> 6;
    const int tn = N / 64, nt = (Mrows / 64) * tn;
    for (int tile = gw; tile < nt; tile += nw) {
        const int row0 = (tile / tn) * 64, col0 = (tile % tn) * 64;
        f32x4 acc[4][4];
#pragma unroll
        for (int i = 0; i < 4; ++i)
#pragma unroll
            for (int j = 0; j < 4; ++j) acc[i][j] = (f32x4){0.f, 0.f, 0.f, 0.f};
        for (int k0 = 0; k0 < K; k0 += 32) {
            bf16x8 a[4], b[4];
#pragma unroll
            for (int i = 0; i < 4; ++i) { a[i] = *(const bf16x8*)(A + (size_t)(row0 + 16 * i + fr) * lda + k0 + 8 * fq); b[i] = *(const bf16x8*)(Bt + (size_t)(col0 + 16 * i + fr) * ldb + k0 + 8 * fq); }
#pragma unroll
            for (int i = 0; i < 4; ++i)
#pragma unroll
                for (int j = 0; j < 4; ++j) acc[i][j] = __builtin_amdgcn_mfma_f32_16x16x32_bf16(a[i], b[j], acc[i][j], 0, 0, 0);
        }
#pragma unroll
        for (int i = 0; i < 4; ++i)
#pragma unroll
            for (int j = 0; j < 4; ++j)
#pragma unroll
                for (int e = 0; e < 4; ++e) epi(row0 + 16 * i + 4 * fq + e, col0 + 16 * j + fr, acc[i][j][e]);
    }
}
struct EStoreBf16 { bf16_t* C; int ldc; int pad; __device__ void operator()(int r, int c, float v) const { C[(size_t)r * ldc + c] = (bf16_t)f2bf(v); } };
struct EResidual { float* hf; __device__ void operator()(int r, int c, float v) const { float* p = hf + (size_t)r * D + c; *p = ALPHA * *p + v; } };
struct EKV { bf16_t* K; bf16_t* Vt; __device__ void operator()(int r, int c, float v) const {
    if (c < D) K[(size_t)r * D + c] = (bf16_t)f2bf(v);
    else if (r < M) { const int cc = c - D, h = cc >> 6, d = cc & 63, b = r / LSEQ, t = r % LSEQ; Vt[(((size_t)b * NH + h) * HD + d) * LSEQ + t] = (bf16_t)f2bf(v); } } };

__device__ __forceinline__ void ffn1_simple(const bf16_t* __restrict__ hb, const bf16_t* __restrict__ Wt  , const float* __restrict__ cw  , const float* __restrict__ cb, bf16_t* __restrict__ g  , float* zs) {
    const int tix = opaque_tid(), lane = tix & 63, fr = lane & 15, fq = lane >> 4, wv = tix >> 6;
    const int gw = (blockIdx.x * blockDim.x + tix) >> 6, nw = (gridDim.x * blockDim.x) >> 6;
    const int ngrp = (M + 61) / 62, ncg = DFF / 32, nt = ngrp * ncg;
    float* z = zs + wv * 64 * 65;
    for (int tile = gw; tile < nt; tile += nw) {
        const int base = (tile / ncg) * 62 - 2, jj0 = (tile % ncg) * 32;
        f32x4 acc[4][4];
#pragma unroll
        for (int i = 0; i < 4; ++i)
#pragma unroll
            for (int j = 0; j < 4; ++j) acc[i][j] = (f32x4){0.f, 0.f, 0.f, 0.f};
        for (int k0 = 0; k0 < D; k0 += 32) {
            bf16x8 a[4], b[4];
#pragma unroll
            for (int i = 0; i < 4; ++i) {
                a[i] = *(const bf16x8*)(hb + (long)(base + 16 * i + fr) * D + k0 + 8 * fq);
                const int jj = jj0 + 16 * (i & 1) + fr, brow = (jj >> 7) * 256 + (i >> 1) * 128 + (jj & 127);
                b[i] = *(const bf16x8*)(Wt + (size_t)brow * D + k0 + 8 * fq);
            }
#pragma unroll
            for (int i = 0; i < 4; ++i)
#pragma unroll
                for (int j = 0; j < 4; ++j) acc[i][j] = __builtin_amdgcn_mfma_f32_16x16x32_bf16(a[i], b[j], acc[i][j], 0, 0, 0);
        }
#pragma unroll
        for (int i = 0; i < 4; ++i)
#pragma unroll
            for (int j = 0; j < 4; ++j)
#pragma unroll
                for (int e = 0; e < 4; ++e) z[(16 * i + 4 * fq + e) * 65 + 16 * j + fr] = acc[i][j][e];
        const int jl = lane & 31, jj = jj0 + jl;
        const float wg0 = cw[jj], wg1 = cw[5632 + jj], wg2 = cw[2 * 5632 + jj], bg = cb[jj];
        const float wv0 = cw[DFF + jj], wv1 = cw[5632 + DFF + jj], wv2 = cw[2 * 5632 + DFF + jj], bv = cb[DFF + jj];
        for (int i = 0; i < 31; ++i) {
            const int s = 2 + 2 * i + (lane >> 5), row = base + s;
            if (row < M) {
                const int t = row % LSEQ;
                const float g2 = (t >= 2) ? z[(s - 2) * 65 + jl] : 0.f, g1 = (t >= 1) ? z[(s - 1) * 65 + jl] : 0.f, g0 = z[s * 65 + jl];
                const float v2 = (t >= 2) ? z[(s - 2) * 65 + 32 + jl] : 0.f, v1 = (t >= 1) ? z[(s - 1) * 65 + 32 + jl] : 0.f, v0 = z[s * 65 + 32 + jl];
                float zg = bg; zg += g2 * wg0; zg += g1 * wg1; zg += g0 * wg2;
                float zv = bv; zv += v2 * wv0; zv += v1 * wv1; zv += v0 * wv2;
                g[(size_t)row * DFF + jj] = (bf16_t)f2bf(gelu_tanh(zg) * zv);
            }
        }
    }
}

__device__ __forceinline__ void rglru_simple(const bf16_t* __restrict__ gr  , const float* __restrict__ conv_w  , const float* __restrict__ conv_b,
                             const float* __restrict__ w_r  , const float* __restrict__ b_r, const float* __restrict__ w_i, const float* __restrict__ b_i,
                             const float* __restrict__ lam, bf16_t* __restrict__ y  , float* xs  ) {
    const int tix = opaque_tid();
    for (int unit = blockIdx.x; unit < NB * NLB; unit += gridDim.x) {
        const int b = unit / NLB, n = unit % NLB, d = tix < LB ? tix : 0, ch = n * LB + d;
        const bool act = tix < LB;
        const float c0 = conv_w[ch], c1 = conv_w[DR + ch], c2 = conv_w[2 * DR + ch], c3 = conv_w[3 * DR + ch], cb = conv_b[ch];
        const float br = b_r[ch], bi = b_i[ch], sp = log1p_pos(__expf(-lam[ch]));
        const float* wr = w_r + (size_t)n * LB * LB + d; const float* wi = w_i + (size_t)n * LB * LB + d;
        float r0 = 0.f, r1 = 0.f, r2 = 0.f, h = 0.f;
        for (int t = 0; t < LSEQ; ++t) {
            const size_t row = (size_t)b * LSEQ + t;
            float x = 0.f;
            if (act) {
                const float raw = bf2f(gr[row * 3072 + DR + ch]);
                x = cb; x += r0 * c0; x += r1 * c1; x += r2 * c2; x += raw * c3;
                r0 = r1; r1 = r2; r2 = raw;
                xs[(t & 1) * LB + d] = x;
            }
            __syncthreads();
            if (act) {
                float pr = 0.f, pi = 0.f;
                for (int c = 0; c < LB; ++c) { const float xc = xs[(t & 1) * LB + c]; pr += xc * wr[c * LB]; pi += xc * wi[c * LB]; }
                const float r = sigmoidf_(pr + br), ig = sigmoidf_(pi + bi);
                const float la = -8.f * r * sp, a = __expf(la), u = sqrtf(neg_expm1(2.f * la)) * (ig * x);
                h = a * h + u;
                const float gate = bf2f(gr[row * 3072 + ch]);
                y[row * DR + ch] = (bf16_t)f2bf(gelu_tanh(gate) * h);
            }
        }
        __syncthreads();
    }
}

__device__ __forceinline__ void cumsum_simple(const float* __restrict__ logf, float* __restrict__ ct) {
    if (blockIdx.x != gridDim.x - 1) return;
    const int i = opaque_tid(); if (i >= NB * NH) return;
    float c = 0.f; for (int t = 0; t < LSEQ; ++t) { c += logf[(size_t)i * LSEQ + t]; ct[(size_t)i * LSEQ + t] = c; }
}

__device__ __forceinline__ void attn_simple(const bf16_t* __restrict__ qg  , const bf16_t* __restrict__ kb, const bf16_t* __restrict__ vt, const float* __restrict__ ct, bf16_t* __restrict__ y  ) {
    for (int idx = blockIdx.x * blockDim.x + opaque_tid(); idx < NB * NH * LSEQ; idx += gridDim.x * blockDim.x) {
        const int tq = idx % LSEQ, bh = idx / LSEQ, b = bh / NH, h = bh % NH;
        const size_t row = (size_t)b * LSEQ + tq;
        float qv[HD], o[HD];
#pragma unroll
        for (int d = 0; d < HD; ++d) { qv[d] = bf2f(qg[row * 2048 + h * HD + d]); o[d] = 0.f; }
        const float cq = ct[(size_t)bh * LSEQ + tq];
        float m = -INFINITY, l = 0.f;
        for (int s = 0; s <= tq; ++s) {
            const bf16_t* kr = kb + ((size_t)b * LSEQ + s) * D + h * HD;
            float dot = 0.f;
#pragma unroll
            for (int d = 0; d < HD; ++d) dot += qv[d] * bf2f(kr[d]);
            const float logit = dot * 0.125f + (cq - ct[(size_t)bh * LSEQ + s]);
            const float mn = fmaxf(m, logit), sc = __expf(m - mn), pp = __expf(logit - mn);
            l = l * sc + pp; m = mn;
#pragma unroll
            for (int d = 0; d < HD; ++d) o[d] = o[d] * sc + pp * bf2f(vt[((size_t)bh * HD + d) * LSEQ + s]);
        }
        const float il = 1.f / l;
#pragma unroll
        for (int d = 0; d < HD; ++d) { const float gt = bf2f(qg[row * 2048 + D + h * HD + d]); y[row * D + h * HD + d] = (bf16_t)f2bf(o[d] * il * sigmoidf_(gt)); }
    }
}

__device__ __forceinline__ void cumsum_wave(const float* __restrict__ logf, float* __restrict__ ct) {
    const int tix = opaque_tid(), lane = tix & 63, wv = tix >> 6;
    const int seq = wv * (int)gridDim.x + ((int)gridDim.x - 1 - (int)blockIdx.x);
    if (seq >= NB * NH) return;
    const float* src = logf + (size_t)seq * LSEQ; float* dst = ct + (size_t)seq * LSEQ;
    const int t0 = lane * 33;
    float v[33];
#pragma unroll
    for (int k = 0; k < 33; ++k) { const int t = t0 + k; v[k] = src[t < LSEQ ? t : LSEQ - 1]; if (t >= LSEQ) v[k] = 0.f; }
#pragma unroll
    for (int k = 1; k < 33; ++k) v[k] += v[k - 1];
    const float total = v[32]; float incl = total;
#pragma unroll
    for (int d = 1; d < 64; d <<= 1) { const float y = __builtin_bit_cast(float, __builtin_amdgcn_ds_bpermute(((lane - d) & 63) << 2, __builtin_bit_cast(int, incl))); const float m = lane >= d ? 1.f : 0.f; incl += y * m; }
    const float excl = incl - total;
#pragma unroll
    for (int k = 0; k < 33; ++k) { const int t = t0 + k; if (t < LSEQ) dst[t] = v[k] + excl; }
}
#define LAS __attribute__((address_space(3)))
namespace pg8 {
constexpr int BM = 256, BK = 64, HALF = 128, HTB = HALF * BK * 2, STAGE_BYTES = 8 * HTB, NXCD = 8, WGM = 8;
__device__ __forceinline__ int lds_byte(int r, int c) { const int st = (r >> 4) * 2 + (c >> 5), rr = r & 15, cc = c & 31, ob = rr * 64 + cc * 2; return st * 1024 + (ob ^ (((ob >> 9) & 1) << 5)); }
__device__ __forceinline__ void stage_rc(int b, int& R, int& C) { const int st = b / 1024, sb = b % 1024, swz = sb ^ (((sb >> 9) & 1) << 5); R = (st >> 1) * 16 + swz / 64; C = (st & 1) * 32 + (swz % 64) / 2; }
__device__ __forceinline__ int perm32(int rho) { const int n = rho >> 4, i = rho & 15; return 8 * (i >> 2) + 4 * n + (i & 3); }

struct Job { const bf16_t* A; const bf16_t* Bt; int nM, nN, id, kpiece; };
struct Unit { const char* A; const char* B; int pm, pn, job, nt; };
template <bool OVL> struct Sched {
    Job j0, j1, j2; int nj, K, G, c, ld;
    __device__ __forceinline__ bool next(int i, Unit& u) const {
        long L = (long)i * G + c;
        const int n0 = j0.nM * j0.nN, n1 = nj > 1 ? j1.nM * j1.nN : 0, n2 = nj > 2 ? j2.nM * j2.nN : 0;
        if (L >= (long)n0 + n1 + n2) return false;
        const int sel = L < n0 ? 0 : (L < n0 + n1 ? 1 : 2);
        if (sel == 1) L -= n0; else if (sel == 2) L -= n0 + n1;
        const bf16_t *A0 = j0.A, *A1 = j1.A, *A2 = j2.A, *B0 = j0.Bt, *B1 = j1.Bt, *B2 = j2.Bt;
        const int M0 = j0.nM, M1 = j1.nM, M2 = j2.nM, N0 = j0.nN, N1 = j1.nN, N2 = j2.nN, I0 = j0.id, I1 = j1.id, I2 = j2.id, P0 = j0.kpiece, P1 = j1.kpiece, P2 = j2.kpiece;
        const bf16_t* jA = sel == 0 ? A0 : (sel == 1 ? A1 : A2); const bf16_t* jB = sel == 0 ? B0 : (sel == 1 ? B1 : B2);
        const int nM = sel == 0 ? M0 : (sel == 1 ? M1 : M2), nN = sel == 0 ? N0 : (sel == 1 ? N1 : N2), nwg = nM * nN;
        u.job = sel == 0 ? I0 : (sel == 1 ? I1 : I2); const int kp = sel == 0 ? P0 : (sel == 1 ? P1 : P2);
        int wgid = (int)L; { const int q = nwg / NXCD, r = nwg % NXCD, xcd = wgid % NXCD, off = wgid / NXCD; wgid = (xcd < r ? xcd * (q + 1) : r * (q + 1) + (xcd - r) * q) + off; }
        const int nig = WGM * nN, gid = wgid / nig, fm = gid * WGM, gsz = (nM - fm) < WGM ? (nM - fm) : WGM;
        u.pm = fm + ((wgid % nig) % gsz); u.pn = (wgid % nig) / gsz;
        u.A = (const char*)jA + (kp ? (long)u.pm * kp * 2 : (OVL ? ((long)u.pm * 252 - 2) : (long)u.pm * 256) * ld * 2);
        u.B = (const char*)jB + (long)u.pn * 256 * ld * 2 + (kp ? (long)u.pm * kp * 2 : 0L);
        u.nt = (kp ? kp : K) / BK;
        return true;
    }
};

template <class Epi, bool OVL>
__device__ __forceinline__ void gemm_phase(LAS unsigned char* lds, const Sched<OVL> S, const Epi E) {
    const int wid = __builtin_amdgcn_readfirstlane(opaque_tid() >> 6), wr = wid >> 2, wc = wid & 3;
    const int K = S.ld;
    unsigned voffA[2], voffB[2]; int aoff, boff;
#define PG8_LANE_SETUP() do { const int tid = opaque_tid(), lane = tid & 63, fr = lane & 15, fq = lane >> 4; \
        _Pragma("unroll") for (int i = 0; i < 2; ++i) { int R, C; stage_rc(tid * 16 + i * 8192, R, C); const int Rb = Epi::PERM ? ((R & ~31) + perm32(R & 31)) : R; const int Ra = OVL ? (R + 62 * (R >> 6)) : R; \
            voffA[i] = (unsigned)(Ra * K + C) * 2u; voffB[i] = (unsigned)(Rb * K + C) * 2u; } \
        aoff = lds_byte(wr * 64 + fr, fq * 8); boff = lds_byte(wc * 32 + fr, fq * 8); } while (0)
    PG8_LANE_SETUP();
    const size_t kstep = (size_t)(BK * 2);
    const size_t hstep = (size_t)HALF * K * 2;
    const size_t hstepA = OVL ? (size_t)64 * K * 2 : hstep;
    const unsigned ldsw = (unsigned)wid * 1024u;
#define PG8_SA(b, h) (((b) * 2 + (h)) * HTB)
#define PG8_SB(b, h) ((4 + (b) * 2 + (h)) * HTB)
#define PG8_STAGE(bufoff, gbase, voff) do { _Pragma("unroll") for (int _i = 0; _i < 2; ++_i) \
        __builtin_amdgcn_global_load_lds((const unsigned*)((const char*)(gbase) + (voff)[_i]), (LAS unsigned*)(lds + (bufoff) + ldsw + _i * 8192), 16, 0, 0); } while (0)
#define PG8_LDA(dst, b, h) do { _Pragma("unroll") for (int m = 0; m < 4; ++m) _Pragma("unroll") for (int k = 0; k < 2; ++k) dst[m][k] = *(const LAS bf16x8*)(lds + PG8_SA(b, h) + aoff + m * 2048 + k * 1024); } while (0)
#define PG8_LDB(dst, b, h) do { _Pragma("unroll") for (int n = 0; n < 2; ++n) _Pragma("unroll") for (int k = 0; k < 2; ++k) dst[n][k] = *(const LAS bf16x8*)(lds + PG8_SB(b, h) + boff + n * 2048 + k * 1024); } while (0)
#define PG8_MMA(ai, bj, At, Bt) do { __builtin_amdgcn_s_setprio(1); _Pragma("unroll") for (int m = 0; m < 4; ++m) _Pragma("unroll") for (int n = 0; n < 2; ++n) _Pragma("unroll") for (int k = 0; k < 2; ++k) \
        acc[ai][bj][m][n] = __builtin_amdgcn_mfma_f32_16x16x32_bf16(Bt[n][k], At[m][k], acc[ai][bj][m][n], 0, 0, 0); __builtin_amdgcn_s_setprio(0); } while (0)
#define PG8_WAIT_V(n) asm volatile("s_waitcnt vmcnt(" #n ")" ::: "memory")
#define PG8_WAIT_L(n) asm volatile("s_waitcnt lgkmcnt(" #n ")" ::: "memory")
#define PG8_BAR __builtin_amdgcn_s_barrier()
#define PG8_SCHED __builtin_amdgcn_sched_barrier(0)
    Unit cur, nxt; int ui = 0;
    if (!S.next(0, cur)) return;
    f32x4 acc[2][2][4][2];
#pragma unroll
    for (int a = 0; a < 2; ++a)
#pragma unroll
        for (int b = 0; b < 2; ++b)
#pragma unroll
            for (int m = 0; m < 4; ++m)
#pragma unroll
                for (int n = 0; n < 2; ++n) acc[a][b][m][n] = (f32x4){0.f, 0.f, 0.f, 0.f};
    bf16x8 At[4][2], B0[2][2], B1[2][2];
    const char* cA = cur.A; const char* cB = cur.B;
    PG8_STAGE(PG8_SB(0, 0), cB, voffB); PG8_STAGE(PG8_SB(0, 1), cB + hstep, voffB); PG8_STAGE(PG8_SA(0, 0), cA, voffA); PG8_STAGE(PG8_SA(0, 1), cA + hstepA, voffA);
    if (wr == 1) PG8_BAR;
    PG8_WAIT_V(2); PG8_BAR;
    PG8_STAGE(PG8_SB(1, 0), cB + kstep, voffB); PG8_STAGE(PG8_SA(1, 0), cA + kstep, voffA); PG8_STAGE(PG8_SB(1, 1), cB + hstep + kstep, voffB);
    PG8_WAIT_V(6); PG8_BAR;
    for (;;) {
        const bool has_next = S.next(ui + 1, nxt);
        const char* nA = has_next ? nxt.A : cA; const char* nB = has_next ? nxt.B : cB;
        const int nt = cur.nt;
        for (int t = 0; t < nt; t += 2) {
            const bool last = (t == nt - 2);
            const char* a1 = cA + (size_t)(t + 1) * kstep;
            const char* a2 = last ? nA : cA + (size_t)(t + 2) * kstep; const char* b2 = last ? nB : cB + (size_t)(t + 2) * kstep;
            const char* a3 = a2 + kstep; const char* b3 = b2 + kstep;
            PG8_LDB(B0, 0, 0); PG8_LDB(B1, 0, 1); PG8_SCHED; PG8_LDA(At, 0, 0); PG8_STAGE(PG8_SA(1, 1), a1 + hstepA, voffA);
            PG8_WAIT_V(8); PG8_WAIT_L(0); PG8_BAR; PG8_MMA(0, 0, At, B0); PG8_MMA(0, 1, At, B1); PG8_BAR; PG8_SCHED;
            PG8_LDA(At, 0, 1); PG8_STAGE(PG8_SB(0, 0), b2, voffB); PG8_STAGE(PG8_SB(0, 1), b2 + hstep, voffB); PG8_STAGE(PG8_SA(0, 0), a2, voffA);
            PG8_WAIT_V(8); PG8_WAIT_L(0); PG8_BAR; PG8_MMA(1, 0, At, B0); PG8_MMA(1, 1, At, B1); PG8_BAR; PG8_SCHED;
            PG8_LDB(B0, 1, 0); PG8_LDB(B1, 1, 1); PG8_SCHED; PG8_LDA(At, 1, 0); PG8_STAGE(PG8_SA(0, 1), a2 + hstepA, voffA);
            PG8_WAIT_V(8); PG8_WAIT_L(0); PG8_BAR; PG8_MMA(0, 0, At, B0); PG8_MMA(0, 1, At, B1); PG8_BAR; PG8_SCHED;
            PG8_LDA(At, 1, 1); PG8_STAGE(PG8_SB(1, 0), b3, voffB); PG8_STAGE(PG8_SB(1, 1), b3 + hstep, voffB); PG8_STAGE(PG8_SA(1, 0), a3, voffA);
            PG8_WAIT_V(8); PG8_WAIT_L(0); PG8_BAR; PG8_MMA(1, 0, At, B0); PG8_MMA(1, 1, At, B1); PG8_BAR; PG8_SCHED;
        }
        if (wr == 0) PG8_BAR;
        E(acc, cur, wr, wc);
        if (!has_next) break;
#pragma unroll
        for (int a = 0; a < 2; ++a)
#pragma unroll
            for (int b = 0; b < 2; ++b)
#pragma unroll
                for (int m = 0; m < 4; ++m)
#pragma unroll
                    for (int n = 0; n < 2; ++n) acc[a][b][m][n] = (f32x4){0.f, 0.f, 0.f, 0.f};
        cur = nxt; cA = nA; cB = nB; ++ui;
        PG8_LANE_SETUP();
        if (wr == 1) PG8_BAR;
    }
    PG8_WAIT_V(0);
    PG8_BAR;
#undef PG8_LANE_SETUP
#undef PG8_SA
#undef PG8_SB
#undef PG8_STAGE
#undef PG8_LDA
#undef PG8_LDB
#undef PG8_MMA
#undef PG8_WAIT_V
#undef PG8_WAIT_L
#undef PG8_BAR
#undef PG8_SCHED
}

__device__ __forceinline__ unsigned cvt_pk_bf16(float lo, float hi) { unsigned r; asm volatile("v_cvt_pk_bf16_f32 %0, %1, %2" : "=v"(r) : "v"(lo), "v"(hi)); return r; }
__device__ __forceinline__ u32x4 pack8(const f32x4& v0, const f32x4& v1) { u32x4 w; w.x = cvt_pk_bf16(v0[0], v0[1]); w.y = cvt_pk_bf16(v0[2], v0[3]); w.z = cvt_pk_bf16(v1[0], v1[1]); w.w = cvt_pk_bf16(v1[2], v1[3]); return w; }

struct EpiStore { static constexpr bool PERM = true;
    bf16_t* O0; bf16_t* Vt; bf16_t* O2; int ld0, ld2; float qs = 1.f;
    __device__ __forceinline__ void operator()(f32x4 (&acc)[2][2][4][2], const Unit& u, int wr, int wc) const {
        const int lane_ = opaque_tid() & 63, fr = lane_ & 15, fq = lane_ >> 4;
        const int row0 = u.pm * BM + wr * 64 + fr, col0 = u.pn * BM + wc * 32 + 8 * fq;
        if (u.job == 1) {
#pragma unroll
            for (int bj = 0; bj < 2; ++bj) { const int tok = col0 + bj * HALF; if (tok < M) { const int b = tok / LSEQ, t = tok % LSEQ;
#pragma unroll
                for (int ai = 0; ai < 2; ++ai)
#pragma unroll
                    for (int m = 0; m < 4; ++m) { const int f = row0 + ai * HALF + m * 16; *(u32x4*)(Vt + ((size_t)(b * NH + (f >> 6)) * HD + (f & 63)) * LSEQ + t) = pack8(acc[ai][bj][m][0], acc[ai][bj][m][1]); } } }
        } else {
            bf16_t* O = u.job == 0 ? O0 : O2; const int ldc = u.job == 0 ? ld0 : ld2;
            if (u.job == 2 && qs != 1.f && u.pn < 4) {
#pragma unroll
                for (int ai = 0; ai < 2; ++ai)
#pragma unroll
                    for (int m = 0; m < 4; ++m) { bf16_t* rowp = O + (size_t)(row0 + ai * HALF + m * 16) * ldc + col0;
#pragma unroll
                        for (int bj = 0; bj < 2; ++bj) *(u32x4*)(rowp + bj * HALF) = pack8(acc[ai][bj][m][0] * qs, acc[ai][bj][m][1] * qs); }
            } else
#pragma unroll
            for (int ai = 0; ai < 2; ++ai)
#pragma unroll
                for (int m = 0; m < 4; ++m) { bf16_t* rowp = O + (size_t)(row0 + ai * HALF + m * 16) * ldc + col0;
#pragma unroll
                    for (int bj = 0; bj < 2; ++bj) *(u32x4*)(rowp + bj * HALF) = pack8(acc[ai][bj][m][0], acc[ai][bj][m][1]); }
        }
    }
};
struct EpiResidual { static constexpr bool PERM = false;
    float* hf;
    __device__ __forceinline__ void operator()(f32x4 (&acc)[2][2][4][2], const Unit& u, int wr, int wc) const {
        const int lane_ = opaque_tid() & 63, fr = lane_ & 15, fq = lane_ >> 4;
        const int row0 = u.pm * BM + wr * 64 + fr, col0 = u.pn * BM + wc * 32 + 4 * fq;
#pragma unroll
        for (int ai = 0; ai < 2; ++ai)
#pragma unroll
            for (int m = 0; m < 4; ++m) { float* rowp = hf + (size_t)(row0 + ai * HALF + m * 16) * D + col0;
#pragma unroll
                for (int bj = 0; bj < 2; ++bj)
#pragma unroll
                    for (int n = 0; n < 2; ++n) { f32x4* pp = (f32x4*)(rowp + bj * HALF + n * 16); *pp = *pp * ALPHA + acc[ai][bj][m][n]; }
                __builtin_amdgcn_sched_barrier(0); }
    }
};
template <int CTRL> __device__ __forceinline__ float dpp_old(float old, float x) { return __builtin_bit_cast(float, __builtin_amdgcn_update_dpp(__builtin_bit_cast(int, old), __builtin_bit_cast(int, x), CTRL, 0xf, 0xf, false)); }
template <int CTRL> __device__ __forceinline__ float dppf(float x) { return __builtin_bit_cast(float, __builtin_amdgcn_update_dpp(0, __builtin_bit_cast(int, x), CTRL, 0xf, 0xf, true)); }
struct EpiFfn1 { static constexpr bool PERM = true;
    bf16_t* g; const float* cw; const float* cb; LAS float* cwl;
    __device__ __forceinline__ void operator()(f32x4 (&acc)[2][2][4][2], const Unit& u, int wr, int wc) const {
        const int lane_ = opaque_tid() & 63, fr = lane_ & 15, fq = lane_ >> 4;
        const int G0 = u.pm * 252 + wr * 126 - 2, jj0 = u.pn * 128 + wc * 32 + 8 * fq;
        { const int tid = opaque_tid();
#pragma unroll
          for (int i = 0; i < 2; ++i) { const int idx = tid + 512 * i, k = idx >> 8, c = idx & 255, ch = (c >> 7) * DFF + u.pn * 128 + (c & 127);
              cwl[idx] = k < 3 ? cw[k * 5632 + ch] : cb[ch]; }
          asm volatile("s_waitcnt lgkmcnt(0)" ::: "memory"); __builtin_amdgcn_s_barrier(); asm volatile("" ::: "memory"); }
        const int cl0 = wc * 32 + 8 * fq;
#pragma unroll
        for (int blk = 0; blk < 8; ++blk) {
            const int ai = blk >> 2, m = blk & 3, off = 64 * ai + 16 * m + fr, row = G0 + off; const unsigned t = (unsigned)(row + LSEQ) % (unsigned)LSEQ;
            const float tm1 = t >= 1u ? 1.f : 0.f, tm2 = t >= 2u ? 1.f : 0.f;
            f32x4 o[2];
#pragma unroll
            for (int n = 0; n < 2; ++n) {
                f32x4 cv[2];
#pragma unroll
                for (int bj = 0; bj < 2; ++bj) {
                    const int ci = bj * 128 + cl0 + 4 * n;
                    const f32x4 w0 = *(const LAS f32x4*)(cwl + ci), w1 = *(const LAS f32x4*)(cwl + 256 + ci), w2 = *(const LAS f32x4*)(cwl + 512 + ci), bb = *(const LAS f32x4*)(cwl + 768 + ci);
                    const f32x4 cur = acc[ai][bj][m][n]; const f32x4 prev = blk > 0 ? acc[(blk > 0 ? blk - 1 : 0) >> 2][bj][(blk > 0 ? blk - 1 : 0) & 3][n] : (f32x4){0.f, 0.f, 0.f, 0.f};
#pragma unroll
                    for (int e = 0; e < 4; ++e) {
                        const float mp = dppf<0x140>(prev[e]), mps = dppf<0xB1>(mp);
                        const float s1 = dppf<0x111>(cur[e]), s2 = dppf<0x112>(cur[e]);
                        float p1 = fr >= 1 ? s1 : mp, p2 = fr >= 2 ? s2 : mps;
                        p1 = t >= 1u ? p1 : 0.f; p2 = t >= 2u ? p2 : 0.f;
                        float r = bb[e]; r += p2 * w0[e]; r += p1 * w1[e]; r += cur[e] * w2[e]; cv[bj][e] = r;
                    }
                }
#pragma unroll
                for (int e = 0; e < 4; ++e) o[n][e] = gelu_tanh(cv[0][e]) * cv[1][e];
            }
            if (off >= 2 && row < M) *(u32x4*)(g + (size_t)row * DFF + jj0) = pack8(o[0], o[1]);
            __builtin_amdgcn_sched_barrier(0);
        }
    }
};
}
constexpr int SC_WSM = 0, SC_PAR = 2 * LB * 104 * 2  , SC_WAVE = SC_PAR + 3 * LB * 4  , SC_WSTRIDE = 16 * 100 * 4 + 16 * 104 * 2  ;
static_assert(SC_WAVE + 8 * SC_WSTRIDE <= 139264, "scan LDS");
template <int CTRL> __device__ __forceinline__ float dpp_id1(float x) { return __builtin_bit_cast(float, __builtin_amdgcn_update_dpp(0x3f800000, __builtin_bit_cast(int, x), CTRL, 0xf, 0xf, false)); }
template <int PASS>
__device__ __forceinline__ void scan_phase(const Params& p, const Ptrs& q, int layer, unsigned char* smem) {
    const int tix = opaque_tid(), lane = tix & 63, wv = __builtin_amdgcn_readfirstlane(tix >> 6), fr = lane & 15, fq = lane >> 4;
    bf16_t* wsm = (bf16_t*)(smem + SC_WSM); float* par = (float*)(smem + SC_PAR);
    float* xs = (float*)(smem + SC_WAVE + wv * SC_WSTRIDE); bf16_t* xb = (bf16_t*)(smem + SC_WAVE + wv * SC_WSTRIDE + 6400);
    const bf16_t* gr = q.big + (size_t)PADR * 3072; bf16_t* ya = q.yb + (size_t)PADR * DR;
    float* aggA = q.agg; float* aggH = q.agg + (size_t)NB * NCH * DR;
    const float* conv_w = p.a_conv_w + (size_t)layer * 4 * DR; const float* conv_b = p.a_conv_b + (size_t)layer * DR;
    int cur_n = -1;
    for (int bu = blockIdx.x; bu < NLB * NCH; bu += gridDim.x) {
        const int n = bu % NLB, g = bu / NLB;
        const int pidx = 8 * g + wv, b = pidx / NCH, c = pidx % NCH, t0 = TCH * c;
        const bool cl = lane < 48; const int chp = n * LB + 2 * (cl ? lane : 0);
        const bf16_t* rp0 = gr + ((size_t)b * LSEQ + t0) * 3072 + DR + chp;
        unsigned rawn[16];
#pragma unroll
        for (int tt = 0; tt < 16; ++tt) rawn[tt] = *(const unsigned*)(rp0 + (size_t)tt * 3072);
        const unsigned u0 = (t0 >= 3) ? *(const unsigned*)(rp0 - 3 * 3072) : 0u, u1 = (t0 >= 2) ? *(const unsigned*)(rp0 - 2 * 3072) : 0u, u2 = (t0 >= 1) ? *(const unsigned*)(rp0 - 3072) : 0u;
        if (n != cur_n) {
            __syncthreads();
            for (int i = tix; i < 2 * LB * 12; i += 512) { const int gate = i / (LB * 12), rem = i % (LB * 12), d = rem / 12, c8 = rem % 12;
                *(u32x4*)(wsm + (gate * LB + d) * 104 + c8 * 8) = *(const u32x4*)(q.wri + ((((size_t)gate * 2 + layer) * NLB + n) * LB + d) * LB + c8 * 8); }
            if (tix < LB) { const int ch = layer * DR + n * LB + tix; par[tix] = p.a_b_r[ch]; par[LB + tix] = p.a_b_i[ch]; par[2 * LB + tix] = log1p_pos(__expf(-p.a_lambda[ch])); }
            __syncthreads();
            cur_n = n;
        }
        float cw0[2], cw1[2], cw2[2], cw3[2], cbv[2], h0[2], h1[2], h2[2];
#pragma unroll
        for (int e = 0; e < 2; ++e) { cw0[e] = conv_w[chp + e]; cw1[e] = conv_w[DR + chp + e]; cw2[e] = conv_w[2 * DR + chp + e]; cw3[e] = conv_w[3 * DR + chp + e]; cbv[e] = conv_b[chp + e]; }
        h0[0] = bf2f(u0 & 0xffffu); h0[1] = bf2f(u0 >> 16); h1[0] = bf2f(u1 & 0xffffu); h1[1] = bf2f(u1 >> 16); h2[0] = bf2f(u2 & 0xffffu); h2[1] = bf2f(u2 >> 16);
        f32x4 hc[6], Ac[6];
#pragma unroll
        for (int db = 0; db < 6; ++db) { hc[db] = (f32x4){0.f, 0.f, 0.f, 0.f}; Ac[db] = (f32x4){1.f, 1.f, 1.f, 1.f}; }
        if (PASS == 2) {
#pragma unroll
            for (int db = 0; db < 6; ++db) hc[db] = *(const f32x4*)(q.hin + ((size_t)b * NCH + c) * DR + n * LB + 16 * db + 4 * fq);
        }
        for (int s = 0; s < 3; ++s) {
            const size_t rowb = (size_t)b * LSEQ + t0 + 16 * s;
            unsigned raw[16];
#pragma unroll
            for (int tt = 0; tt < 16; ++tt) raw[tt] = rawn[tt];
            if (s < 2) {
#pragma unroll
                for (int tt = 0; tt < 16; ++tt) rawn[tt] = *(const unsigned*)(rp0 + (size_t)(16 * (s + 1) + tt) * 3072);
            }
            u32x2 gg[6];
            if (PASS == 2) {
#pragma unroll
                for (int db = 0; db < 6; ++db) gg[db] = *(const u32x2*)(gr + (rowb + fr) * 3072 + n * LB + 16 * db + 4 * fq);
            }
            if (cl) {
#pragma unroll
                for (int tt = 0; tt < 16; ++tt) {
                    const unsigned uu = raw[tt]; const float r0 = bf2f(uu & 0xffffu), r1 = bf2f(uu >> 16);
                    float x0 = cbv[0]; x0 += h0[0] * cw0[0]; x0 += h1[0] * cw1[0]; x0 += h2[0] * cw2[0]; x0 += r0 * cw3[0];
                    float x1 = cbv[1]; x1 += h0[1] * cw0[1]; x1 += h1[1] * cw1[1]; x1 += h2[1] * cw2[1]; x1 += r1 * cw3[1];
                    h0[0] = h1[0]; h1[0] = h2[0]; h2[0] = r0; h0[1] = h1[1]; h1[1] = h2[1]; h2[1] = r1;
                    xs[tt * 100 + 2 * lane] = x0; xs[tt * 100 + 2 * lane + 1] = x1;
                    *(unsigned*)(xb + tt * 104 + 2 * lane) = pg8::cvt_pk_bf16(x0, x1);
                }
            }
            asm volatile("s_waitcnt lgkmcnt(0)" ::: "memory");
            bf16x8 xf[3];
#pragma unroll
            for (int ks = 0; ks < 3; ++ks) xf[ks] = *(const bf16x8*)(xb + fr * 104 + 32 * ks + 8 * fq);
#pragma unroll
            for (int db = 0; db < 6; ++db) {
                f32x4 pr = (f32x4){0.f, 0.f, 0.f, 0.f}, pi = (f32x4){0.f, 0.f, 0.f, 0.f};
#pragma unroll
                for (int ks = 0; ks < 3; ++ks) {
                    const bf16x8 ar = *(const bf16x8*)(wsm + (16 * db + fr) * 104 + 32 * ks + 8 * fq), ai = *(const bf16x8*)(wsm + (LB + 16 * db + fr) * 104 + 32 * ks + 8 * fq);
                    pr = __builtin_amdgcn_mfma_f32_16x16x32_bf16(ar, xf[ks], pr, 0, 0, 0); pi = __builtin_amdgcn_mfma_f32_16x16x32_bf16(ai, xf[ks], pi, 0, 0, 0);
                }
                const int d0 = 16 * db + 4 * fq;
                const f32x4 br4 = *(const f32x4*)(par + d0), bi4 = *(const f32x4*)(par + LB + d0), sp4 = *(const f32x4*)(par + 2 * LB + d0), x4 = *(const f32x4*)(xs + fr * 100 + d0);
                f32x4 hv;
#pragma unroll
                for (int j = 0; j < 4; ++j) {
                    const float r = sigmoidf_(pr[j] + br4[j]), ig = sigmoidf_(pi[j] + bi4[j]);
                    const float la = -8.f * r * sp4[j];
                    float A = __builtin_amdgcn_exp2f(LOG2E * la), H = __builtin_amdgcn_sqrtf(neg_expm1(2.f * la)) * (ig * x4[j]);
                    { const float Ap = dpp_id1<0x111>(A), Hp = pg8::dppf<0x111>(H); H = A * Hp + H; A = Ap * A; }
                    { const float Ap = dpp_id1<0x112>(A), Hp = pg8::dppf<0x112>(H); H = A * Hp + H; A = Ap * A; }
                    { const float Ap = dpp_id1<0x114>(A), Hp = pg8::dppf<0x114>(H); H = A * Hp + H; A = Ap * A; }
                    { const float Ap = dpp_id1<0x118>(A), Hp = pg8::dppf<0x118>(H); H = A * Hp + H; A = Ap * A; }
                    const float h = A * hc[db][j] + H;
                    hv[j] = h;
                    const int src = ((lane & 48) | 15) << 2;
                    hc[db][j] = __builtin_bit_cast(float, __builtin_amdgcn_ds_bpermute(src, __builtin_bit_cast(int, h)));
                    if (PASS == 1) Ac[db][j] *= __builtin_bit_cast(float, __builtin_amdgcn_ds_bpermute(src, __builtin_bit_cast(int, A)));
                }
                if (PASS == 2) {
                    const size_t row = rowb + fr;
                    const float y0 = gelu_tanh(bf2f(gg[db].x & 0xffffu)) * hv[0], y1 = gelu_tanh(bf2f(gg[db].x >> 16)) * hv[1], y2 = gelu_tanh(bf2f(gg[db].y & 0xffffu)) * hv[2], y3 = gelu_tanh(bf2f(gg[db].y >> 16)) * hv[3];
                    u32x2 w; w.x = pg8::cvt_pk_bf16(y0, y1); w.y = pg8::cvt_pk_bf16(y2, y3);
                    *(u32x2*)(ya + row * DR + n * LB + d0) = w;
                }
            }
        }
        if (PASS == 1 && fr == 0) {
#pragma unroll
            for (int db = 0; db < 6; ++db) { const size_t o = ((size_t)b * NCH + c) * DR + n * LB + 16 * db + 4 * fq; *(f32x4*)(aggA + o) = Ac[db]; *(f32x4*)(aggH + o) = hc[db]; }
        }
    }
}

__device__ __forceinline__ void carry_phase(const Ptrs& q) {
    const int tix_ = opaque_tid(); const int gidx = ((tix_ >> 6) * (int)gridDim.x + (int)blockIdx.x) * 64 + (tix_ & 63);
    if (gidx >= NB * DR) return;
    const int b = gidx / DR, ch = gidx % DR;
    const float* aggA = q.agg + (size_t)b * NCH * DR + ch; const float* aggH = aggA + (size_t)NB * NCH * DR;
    float a[NCH], g[NCH];
#pragma unroll
    for (int cc = 0; cc < NCH; ++cc) { a[cc] = aggA[(size_t)cc * DR]; g[cc] = aggH[(size_t)cc * DR]; }
    float h = 0.f; float* out = q.hin + (size_t)b * NCH * DR + ch;
#pragma unroll
    for (int cc = 0; cc < NCH; ++cc) { out[(size_t)cc * DR] = h; h = a[cc] * h + g[cc]; }
}
constexpr int AT_STRIDE = 72;
constexpr int AT_BUF = 2 * 64 * AT_STRIDE * 2 + 256;
constexpr int AT_MISC = 2 * AT_BUF;
template <bool BAND>
__device__ __forceinline__ void attn_tile(const unsigned char* sb, const bf16x8 (&qf)[2][2], const float (&cq2)[2], float (&mrun)[2], float (&lrun)[2], f32x4 (&o)[2][4],
                                          int i, int j, int wv, int lane, int fr, int fq) {
    const float SC2 = 0.125f * LOG2E;
    const bf16_t* Ks = (const bf16_t*)sb; const bf16_t* Vs = (const bf16_t*)(sb + 64 * AT_STRIDE * 2); const float* Cs = (const float*)(sb + 2 * 64 * AT_STRIDE * 2);
    const bool band = BAND;
    if (!BAND || !(j >= 4 * i && 64 * (j - 4 * i) > 32 * wv + 31)) {
    bf16x8 kf[4][2]; f32x4 cs4[4]; bf16x8 vf[4][2];
#pragma unroll
    for (int kb = 0; kb < 4; ++kb) { kf[kb][0] = *(const bf16x8*)(Ks + (16 * kb + fr) * AT_STRIDE + 8 * fq); kf[kb][1] = *(const bf16x8*)(Ks + (16 * kb + fr) * AT_STRIDE + 32 + 8 * fq); cs4[kb] = *(const f32x4*)(Cs + 16 * kb + 4 * fq); }
    f32x4 s[2][4];
#pragma unroll
    for (int qb = 0; qb < 2; ++qb)
#pragma unroll
        for (int kb = 0; kb < 4; ++kb) {
            f32x4 a = cs4[kb];
            a = __builtin_amdgcn_mfma_f32_16x16x32_bf16(kf[kb][0], qf[qb][0], a, 0, 0, 0);
            a = __builtin_amdgcn_mfma_f32_16x16x32_bf16(kf[kb][1], qf[qb][1], a, 0, 0, 0);
            s[qb][kb] = a;
        }
#pragma unroll
    for (int db = 0; db < 4; ++db)
#pragma unroll
        for (int ks = 0; ks < 2; ++ks) {
            const u32x2 v0 = *(const u32x2*)(Vs + (16 * db + fr) * AT_STRIDE + 32 * ks + 4 * fq), v1 = *(const u32x2*)(Vs + (16 * db + fr) * AT_STRIDE + 32 * ks + 16 + 4 * fq);
            u32x4 w; w.x = v0.x; w.y = v0.y; w.z = v1.x; w.w = v1.y; vf[db][ks] = __builtin_bit_cast(bf16x8, w);
        }
#pragma unroll
    for (int qb = 0; qb < 2; ++qb) {
#pragma unroll
        for (int kb = 0; kb < 4; ++kb) {
            f32x4 a = s[qb][kb];
            if (band) {
                const int pq = 256 * i + 32 * wv + 16 * qb + fr, pk = 64 * j + 16 * kb + 4 * fq;
#pragma unroll
                for (int e = 0; e < 4; ++e) a[e] = (pk + e >= 240 && pk + e <= pq) ? a[e] : -INFINITY;
            }
            s[qb][kb] = a;
        }
        float mx = s[qb][0][0];
#define MX3(a, b, c) __builtin_fmaxf(__builtin_fmaxf((a), (b)), (c))
        mx = MX3(mx, s[qb][0][1], s[qb][0][2]); mx = MX3(mx, s[qb][0][3], s[qb][1][0]); mx = MX3(mx, s[qb][1][1], s[qb][1][2]); mx = MX3(mx, s[qb][1][3], s[qb][2][0]);
        mx = MX3(mx, s[qb][2][1], s[qb][2][2]); mx = MX3(mx, s[qb][2][3], s[qb][3][0]); mx = MX3(mx, s[qb][3][1], s[qb][3][2]); mx = __builtin_fmaxf(mx, s[qb][3][3]);
#undef MX3
        { const auto r16 = __builtin_amdgcn_permlane16_swap(__builtin_bit_cast(unsigned, mx), __builtin_bit_cast(unsigned, mx), false, false);
          mx = __builtin_fmaxf(__builtin_bit_cast(float, r16[0]), __builtin_bit_cast(float, r16[1]));
          const auto r32 = __builtin_amdgcn_permlane32_swap(__builtin_bit_cast(unsigned, mx), __builtin_bit_cast(unsigned, mx), false, false);
          mx = __builtin_fmaxf(__builtin_bit_cast(float, r32[0]), __builtin_bit_cast(float, r32[1])); }
        const float mn = fmaxf(mrun[qb], mx), scl = __builtin_amdgcn_exp2f(mrun[qb] - mn);
        mrun[qb] = mn;
        f32x4 rs4 = (f32x4){0.f, 0.f, 0.f, 0.f};
#pragma unroll
        for (int kb = 0; kb < 4; ++kb) { const f32x4 t = s[qb][kb] - mn; f32x4 pe;
#pragma unroll
            for (int e = 0; e < 4; ++e) pe[e] = __builtin_amdgcn_exp2f(t[e]);
            s[qb][kb] = pe; rs4 = rs4 + pe; }
        const float rs = (rs4[0] + rs4[1]) + (rs4[2] + rs4[3]);
        lrun[qb] = lrun[qb] * scl + rs;
#pragma unroll
        for (int db = 0; db < 4; ++db) o[qb][db] = o[qb][db] * scl;
        bf16x8 pf[2];
#pragma unroll
        for (int ks = 0; ks < 2; ++ks) { const u32x4 w = pg8::pack8(s[qb][2 * ks], s[qb][2 * ks + 1]); pf[ks] = __builtin_bit_cast(bf16x8, w); }
#pragma unroll
        for (int db = 0; db < 4; ++db)
#pragma unroll
            for (int ks = 0; ks < 2; ++ks) o[qb][db] = __builtin_amdgcn_mfma_f32_16x16x32_bf16(vf[db][ks], pf[ks], o[qb][db], 0, 0, 0);
    }
    }
}
__device__ __forceinline__ void attn_phase(const Ptrs& q, const bf16_t* __restrict__ qg, bf16_t* __restrict__ yb, unsigned char* smem, unsigned* queue, bool skel = false) {
    const int tix = opaque_tid(), lane = tix & 63, wv = __builtin_amdgcn_readfirstlane(tix >> 6), fr = lane & 15, fq = lane >> 4;
    const float SC2 = 0.125f * LOG2E;
    volatile int* misc = (volatile int*)(smem + AT_MISC);
    for (;;) {
        __syncthreads();
        if (tix == 0) misc[0] = (int)__hip_atomic_fetch_add(queue, 1u, __ATOMIC_RELAXED, __HIP_MEMORY_SCOPE_AGENT);
        __syncthreads();
        const int u = misc[0];
        if (u >= 9 * NB * NH) break;
        const int i = 8 - u / (NB * NH), bh = u % (NB * NH), b = bh / NH, h = bh % NH;
        const size_t rowb = (size_t)b * LSEQ;
        const float* cbh = q.ct + (size_t)bh * LSEQ;
        bf16x8 qf[2][2]; float cq2[2], mrun[2], lrun[2]; f32x4 o[2][4];
#pragma unroll
        for (int qb = 0; qb < 2; ++qb) {
            const int tq = 256 * i + 32 * wv + 16 * qb + fr - 240, tqc = tq < 0 ? 0 : tq;
            const bf16_t* qp = qg + (rowb + tqc) * 2048 + h * HD + 8 * fq;
            qf[qb][0] = *(const bf16x8*)(qp); qf[qb][1] = *(const bf16x8*)(qp + 32);
            cq2[qb] = cbh[tqc] * LOG2E; mrun[qb] = -INFINITY; lrun[qb] = 0.f;
#pragma unroll
            for (int db = 0; db < 4; ++db) o[qb][db] = (f32x4){0.f, 0.f, 0.f, 0.f};
        }
        const int lr = tix >> 3, lc = tix & 7;
        const int j0 = 3, j1 = 4 * i + 3;
        u32x4 kA, vA, kB, vB, kC, vC; float cA = 0.f, cB = 0.f, cC = 0.f;
#define AT_LOAD(j, KR, VR, CR) do { const int jl_ = (j) < j1 ? (j) : j1; const int tk = 64 * jl_ - 240 + lr, tkc = tk < 0 ? 0 : tk; \
            KR = *(const u32x4*)(q.kb + (rowb + tkc) * D + h * HD + 8 * lc); \
            const int tv = 64 * jl_ - 240 + 8 * lc, tvc = tv < 0 ? 0 : tv; \
            VR = *(const u32x4*)(q.vt + ((size_t)bh * HD + lr) * LSEQ + tvc); \
            { const int tc = 64 * jl_ - 240 + (tix & 63); CR = cbh[tc < 0 ? 0 : tc]; } } while (0)
#define AT_STEP(jj, KR, VR, CR) do { unsigned char* sb = smem + buf * AT_BUF; \
            *(u32x4*)((bf16_t*)sb + lr * AT_STRIDE + 8 * lc) = KR; *(u32x4*)((bf16_t*)(sb + 64 * AT_STRIDE * 2) + lr * AT_STRIDE + 8 * lc) = VR; if (tix < 64) ((float*)(sb + 2 * 64 * AT_STRIDE * 2))[tix] = CR * -LOG2E; \
            __syncthreads(); \
            AT_LOAD((jj) + 3, KR, VR, CR); \
            if (!skel) { if ((jj) == 3 || (jj) >= 4 * i) attn_tile<true>(sb, qf, cq2, mrun, lrun, o, i, (jj), wv, lane, fr, fq); else attn_tile<false>(sb, qf, cq2, mrun, lrun, o, i, (jj), wv, lane, fr, fq); } \
            buf ^= 1; } while (0)
        AT_LOAD(j0, kA, vA, cA); AT_LOAD(j0 + 1, kB, vB, cB); AT_LOAD(j0 + 2, kC, vC, cC);
        int buf = 0;
        for (int j = j0; j <= j1; j += 3) {
            AT_STEP(j, kA, vA, cA);
            if (j + 1 <= j1) AT_STEP(j + 1, kB, vB, cB);
            if (j + 2 <= j1) AT_STEP(j + 2, kC, vC, cC);
        }
#undef AT_STEP
#undef AT_LOAD
#pragma unroll
        for (int qb = 0; qb < 2; ++qb) {
            float l = lrun[qb]; l += shfl_xor_f(l, lane, 16); l += shfl_xor_f(l, lane, 32);
            const float il = __builtin_amdgcn_rcpf(l);
            const int tq = 256 * i + 32 * wv + 16 * qb + fr - 240;
            if (tq >= 0 && !skel) {
                const size_t row = rowb + tq;
#pragma unroll
                for (int db = 0; db < 4; ++db) {
                    const int col = h * HD + 16 * db + 4 * fq;
                    const u32x2 gg = *(const u32x2*)(qg + row * 2048 + D + col);
                    const float y0 = o[qb][db][0] * il * sigmoidf_(bf2f(gg.x & 0xffffu)), y1 = o[qb][db][1] * il * sigmoidf_(bf2f(gg.x >> 16));
                    const float y2 = o[qb][db][2] * il * sigmoidf_(bf2f(gg.y & 0xffffu)), y3 = o[qb][db][3] * il * sigmoidf_(bf2f(gg.y >> 16));
                    u32x2 w; w.x = pk2(y0, y1); w.y = pk2(y2, y3);
                    *(u32x2*)(yb + row * D + col) = w;
                }
            }
        }
    }
}
#ifndef FAST_GEMM
#define FAST_GEMM 1
#endif
#ifdef PROBE_BARRIER
#define PROBE_BAR2 grid_barrier((unsigned*)(p.ws + W_CTL), ++bar_k); grid_barrier((unsigned*)(p.ws + W_CTL), ++bar_k);
#else
#define PROBE_BAR2
#endif
#ifndef FAST_SCAN
#define FAST_SCAN 1
#endif
#ifndef FAST_ATTN
#define FAST_ATTN 1
#endif
#ifndef FAST_FFN1
#define FAST_FFN1 1
#endif
constexpr int LDS_BYTES = 139264;

__device__ __forceinline__ void tail_proj(const bf16_t* __restrict__ A, const bf16_t* __restrict__ Bt, bf16_t* __restrict__ O, int ldo, int nct, int nscaled, float qs) {
    int ct = (int)blockIdx.x; asm volatile("" : "+s"(ct)); if (ct >= nct) return;
    const int tix = opaque_tid(), lane = tix & 63, w = tix >> 6, fr = lane & 15, fq = lane >> 4;
    const bf16_t* ap = A + (size_t)(TAIL0 + 16 * w + fr) * D + 8 * fq;
    const bf16_t* bp = Bt + (size_t)(16 * ct + fr) * D + 8 * fq;
    f32x4 acc = {0.f, 0.f, 0.f, 0.f};
    for (int k0 = 0; k0 < 32; k0 += 8) {
        bf16x8 a[8], b[8];
#pragma unroll
        for (int u = 0; u < 8; ++u) { a[u] = *(const bf16x8*)(ap + (k0 + u) * 32); b[u] = *(const bf16x8*)(bp + (k0 + u) * 32); }
        __builtin_amdgcn_sched_barrier(0);
#pragma unroll
        for (int u = 0; u < 8; ++u) acc = __builtin_amdgcn_mfma_f32_16x16x32_bf16(b[u], a[u], acc, 0, 0, 0);
        __builtin_amdgcn_sched_barrier(0);
    }
    const float sc = ct < nscaled ? qs : 1.f;
    u32x2 o; o.x = pk2(acc[0] * sc, acc[1] * sc); o.y = pk2(acc[2] * sc, acc[3] * sc);
    *(u32x2*)(O + (size_t)(TAIL0 + 16 * w + fr) * ldo + 16 * ct + 4 * fq) = o;
}
template <bool VT> __device__ __forceinline__ void tail_tile(const bf16_t* __restrict__ A, const bf16_t* __restrict__ Bt, bf16_t* __restrict__ O, int ldo, int ct, float sc) {
    const int tix = opaque_tid(), lane = tix & 63, w = tix >> 6, fr = lane & 15, fq = lane >> 4;
    const bf16_t* ap = A + (size_t)(TAIL0 + 16 * w + fr) * D + 8 * fq;
    const bf16_t* bp = Bt + (size_t)(16 * ct + fr) * D + 8 * fq;
    f32x4 acc = {0.f, 0.f, 0.f, 0.f};
    for (int k0 = 0; k0 < 32; k0 += 8) {
        bf16x8 a[8], b[8];
#pragma unroll
        for (int u = 0; u < 8; ++u) { a[u] = *(const bf16x8*)(ap + (k0 + u) * 32); b[u] = *(const bf16x8*)(bp + (k0 + u) * 32); }
        __builtin_amdgcn_sched_barrier(0);
#pragma unroll
        for (int u = 0; u < 8; ++u) acc = VT ? __builtin_amdgcn_mfma_f32_16x16x32_bf16(a[u], b[u], acc, 0, 0, 0)
                                             : __builtin_amdgcn_mfma_f32_16x16x32_bf16(b[u], a[u], acc, 0, 0, 0);
        __builtin_amdgcn_sched_barrier(0);
    }
    u32x2 o; o.x = pk2(acc[0] * sc, acc[1] * sc); o.y = pk2(acc[2] * sc, acc[3] * sc);
    if (VT) { const int f = 16 * ct + fr; *(u32x2*)(O + ((size_t)(7 * NH + (f >> 6)) * HD + (f & 63)) * LSEQ + (TAIL0 - 7 * LSEQ) + 16 * w + 4 * fq) = o; }
    else *(u32x2*)(O + (size_t)(TAIL0 + 16 * w + fr) * ldo + 16 * ct + 4 * fq) = o;
}
__device__ __forceinline__ void tail_kvq(const Ptrs& q, bf16_t* qg) {
    int c0 = (int)blockIdx.x; asm volatile("" : "+s"(c0));
    for (int tile = c0; tile < 256; tile += (int)gridDim.x) {
        if (tile < 64) tail_tile<false>(q.hb, q.bin, qg, 2048, tile, 0.125f * LOG2E);
        else if (tile < 128) tail_tile<false>(q.hb, q.bin, qg, 2048, tile, 1.f);
        else if (tile < 192) tail_tile<false>(q.hb, q.kv, q.kb, D, tile - 128, 1.f);
        else tail_tile<true>(q.hb, q.kv + (size_t)D * D, q.vt, 0, tile - 192, 1.f);
    }
}
__device__ __forceinline__ void grid_barrier(unsigned* ctr, unsigned k) {
    __syncthreads();
    if (opaque_tid() == 0) {
        __builtin_amdgcn_fence(__ATOMIC_RELEASE, "agent");
        const unsigned G = gridDim.x, g = blockIdx.x & 7u, ng = G < 8u ? G : 8u, cnt = (G - g + 7u) >> 3;
        const unsigned old = __hip_atomic_fetch_add(ctr + 64 + 64 * g, 1u, __ATOMIC_RELAXED, __HIP_MEMORY_SCOPE_AGENT);
        if (old == k * cnt - 1u) __hip_atomic_fetch_add(ctr, 1u, __ATOMIC_RELAXED, __HIP_MEMORY_SCOPE_AGENT);
        const unsigned target = k * ng;
        while (__hip_atomic_load(ctr, __ATOMIC_RELAXED, __HIP_MEMORY_SCOPE_AGENT) < target) __builtin_amdgcn_s_sleep(1);
        __builtin_amdgcn_fence(__ATOMIC_ACQUIRE, "agent");
    }
    __syncthreads();
}

typedef const __attribute__((address_space(4))) unsigned char* KARG;
__device__ __forceinline__ Params load_params(KARG pk) {
    const __attribute__((address_space(4))) unsigned long long* k = (const __attribute__((address_space(4))) unsigned long long*)pk;
    Params p;
    p.x = (const float*)(const __attribute__((address_space(1))) float*)k[0];    p.meta = (const float*)(const __attribute__((address_space(1))) float*)k[1];    p.a_w_in = (const float*)(const __attribute__((address_space(1))) float*)k[2];    p.a_conv_w = (const float*)(const __attribute__((address_space(1))) float*)k[3];    p.a_conv_b = (const float*)(const __attribute__((address_space(1))) float*)k[4];    p.a_w_r = (const float*)(const __attribute__((address_space(1))) float*)k[5];    p.a_b_r = (const float*)(const __attribute__((address_space(1))) float*)k[6];    p.a_w_i = (const float*)(const __attribute__((address_space(1))) float*)k[7];    p.a_b_i = (const float*)(const __attribute__((address_space(1))) float*)k[8];    p.a_lambda = (const float*)(const __attribute__((address_space(1))) float*)k[9];    p.a_w_out = (const float*)(const __attribute__((address_space(1))) float*)k[10];    p.kv_w = (const float*)(const __attribute__((address_space(1))) float*)k[11];    p.kv_f_b = (const float*)(const __attribute__((address_space(1))) float*)k[12];    p.b_w_in = (const float*)(const __attribute__((address_space(1))) float*)k[13];    p.b_w_out = (const float*)(const __attribute__((address_space(1))) float*)k[14];    p.f_w_in = (const float*)(const __attribute__((address_space(1))) float*)k[15];    p.f_conv_w = (const float*)(const __attribute__((address_space(1))) float*)k[16];    p.f_conv_b = (const float*)(const __attribute__((address_space(1))) float*)k[17];    p.f_w_out = (const float*)(const __attribute__((address_space(1))) float*)k[18];    p.ln1_g = (const float*)(const __attribute__((address_space(1))) float*)k[19];    p.ln1_b = (const float*)(const __attribute__((address_space(1))) float*)k[20];    p.ln2_g = (const float*)(const __attribute__((address_space(1))) float*)k[21];    p.ln2_b = (const float*)(const __attribute__((address_space(1))) float*)k[22];
    p.out = (float*)(__attribute__((address_space(1))) float*)k[23]; p.ws = (unsigned char*)(__attribute__((address_space(1))) unsigned char*)k[24]; p.ph_lo = 0; p.ph_hi = 0;
    return p;
}
__global__ void __launch_bounds__(512, 2) mega(Params p_in) {
    extern __shared__ __attribute__((aligned(16))) unsigned char smem[];
    LAS unsigned char* lds = (LAS unsigned char*)smem;
    const KARG pk0 = (KARG)__builtin_amdgcn_kernarg_segment_ptr();
    const int G = gridDim.x, bx = blockIdx.x, vcu = (G % 8 == 0) ? (bx % 8) * (G / 8) + bx / 8 : bx;
    const int ph_lo = p_in.ph_lo, ph_hi = p_in.ph_hi;
    int ph = 0; unsigned bar_k = 0;
#define PHASE(...) do { if (ph >= ph_lo && ph < ph_hi) { KARG pk = pk0; asm volatile("" : "+s"(pk)); const Params p = load_params(pk); const Ptrs q = make_ptrs(p); \
        bf16_t* const gr = q.big + (size_t)PADR * 3072; bf16_t* const ya = q.yb + (size_t)PADR * DR; bf16_t* const qg = q.big + (size_t)PADR * 2048; bf16_t* const yb = q.yb + (size_t)PADR * D; bf16_t* const g = q.big + (size_t)PADR * DFF; bf16_t* const mixm = q.big + (size_t)PADR * D; bf16_t* const mixf = q.yb + (size_t)PADR * D; bf16_t* const mixm2 = q.big + (size_t)(ROWS + PADR) * D; bf16_t* const mixf2 = q.hb; (void)mixm; (void)mixf; (void)mixm2; (void)mixf2; \
        (void)gr; (void)ya; (void)qg; (void)yb; (void)g; \
        __VA_ARGS__; \
        if (ph + 1 < ph_hi) { if (ph == 0) cg::this_grid().sync(); else { grid_barrier((unsigned*)(p.ws + W_CTL), ++bar_k); PROBE_BAR2 } } } ++ph; } while (0)
#define PHASE_PRE(...) do { if (ph >= ph_lo && ph < ph_hi) { KARG pk = pk0; asm volatile("" : "+s"(pk)); const Params p = load_params(pk); const Ptrs q = make_ptrs(p); \
        bf16_t* const gr = q.big + (size_t)PADR * 3072; bf16_t* const qg = q.big + (size_t)PADR * 2048; (void)gr; (void)qg; (void)p; \
        __VA_ARGS__; } } while (0)
    PHASE(prologue(p, q, (float*)smem));
#if defined(PROBE_DUP) || defined(PROBE_PRO)
    PHASE(prologue(p, q, (float*)smem));
#endif
    for (int layer = 0; layer < 4; ++layer) {
        if (layer < 2) {
            PHASE_PRE(tail_proj(q.hb, q.ain + (size_t)layer * 3072 * D, gr, 3072, 192, 0, 1.f));
            PHASE({ pg8::Sched<false> S{}; S.j0 = pg8::Job{q.hb, q.ain + (size_t)layer * 3072 * D, 64, 3072 / 256, 0, 0}; S.nj = 1; S.K = D; S.G = G; S.c = bx; S.ld = S.K;
                    pg8::EpiStore E{gr, nullptr, nullptr, 3072, 0}; pg8::gemm_phase<pg8::EpiStore, false>(lds, S, E); });
#if defined(PROBE_DUP2) || defined(PROBE_A1)
            PHASE({ pg8::Sched<false> S{}; S.j0 = pg8::Job{q.hb, q.ain + (size_t)layer * 3072 * D, MP / 256, 3072 / 256, 0, 0}; S.nj = 1; S.K = D; S.G = G; S.c = bx; S.ld = S.K;
                    pg8::EpiStore E{gr, nullptr, nullptr, 3072, 0}; pg8::gemm_phase<pg8::EpiStore, false>(lds, S, E); });
#endif
#if FAST_SCAN
            PHASE(scan_phase<1>(p, q, layer, smem));
            PHASE(carry_phase(q));
            PHASE(scan_phase<2>(p, q, layer, smem));
#if defined(PROBE_DUP) || defined(PROBE_SCAN)
            PHASE(scan_phase<1>(p, q, layer, smem));
            PHASE(scan_phase<2>(p, q, layer, smem));
#endif
#else
            PHASE(rglru_simple(gr, p.a_conv_w + (size_t)layer * 4 * DR, p.a_conv_b + (size_t)layer * DR, p.a_w_r + (size_t)layer * NLB * LB * LB, p.a_b_r + (size_t)layer * DR,
                               p.a_w_i + (size_t)layer * NLB * LB * LB, p.a_b_i + (size_t)layer * DR, p.a_lambda + (size_t)layer * DR, ya, (float*)smem));
#endif
            PHASE({ pg8::Sched<false> S{}; S.j0 = pg8::Job{ya, q.aout + (size_t)layer * D * DR, 64, D / 256, 0, 0}; S.j1 = pg8::Job{ya + (size_t)TAIL0 * DR, q.aout + (size_t)layer * D * DR, DR / 256, D / 256, 2, 256};
                    S.nj = 2; S.K = DR; S.G = G; S.c = bx; S.ld = DR;
                    pg8::EpiStore E{mixm, nullptr, q.part, D, D}; pg8::gemm_phase<pg8::EpiStore, false>(lds, S, E); });
        } else {
            const int j = layer - 2;
            if (j == 0) PHASE_PRE(tail_kvq(q, qg));
            if (j == 0) PHASE({ pg8::Sched<false> S{}; S.j0 = pg8::Job{q.hb, q.bin, 64, 8, 2, 0}; S.j1 = pg8::Job{q.hb, q.kv, 64, 4, 0, 0}; S.j2 = pg8::Job{q.kv + (size_t)D * D, q.hb, 4, 64, 1, 0};
                    S.nj = 3; S.K = D; S.G = G; S.c = bx; S.ld = S.K;
                    pg8::EpiStore E{q.kb, q.vt, qg, D, 2048, 0.125f * LOG2E}; pg8::gemm_phase<pg8::EpiStore, false>(lds, S, E);
                    cumsum_wave(q.logf, q.ct); });
            if (j != 0) PHASE_PRE(tail_proj(q.hb, q.bin + (size_t)2048 * D, qg, 2048, 128, 64, 0.125f * LOG2E));
            if (j != 0) PHASE({ pg8::Sched<false> S{}; S.j0 = pg8::Job{q.hb, q.bin + (size_t)2048 * D, 64, 8, 2, 0}; S.nj = 1; S.K = D; S.G = G; S.c = bx; S.ld = S.K;
                    pg8::EpiStore E{q.kb, q.vt, qg, D, 2048, 0.125f * LOG2E}; pg8::gemm_phase<pg8::EpiStore, false>(lds, S, E); });
#ifdef PROBE_DUP2
            if (j == 0) PHASE({ pg8::Sched<false> S{}; S.j0 = pg8::Job{q.hb, q.bin, MP / 256, 8, 2, 0}; S.j1 = pg8::Job{q.hb, q.kv, MP / 256, 4, 0, 0}; S.j2 = pg8::Job{q.kv + (size_t)D * D, q.hb, 4, MP / 256, 1, 0};
                    S.nj = 3; S.K = D; S.G = G; S.c = bx; S.ld = S.K;
                    pg8::EpiStore E{q.kb, q.vt, qg, D, 2048, 0.125f * LOG2E}; pg8::gemm_phase<pg8::EpiStore, false>(lds, S, E);
                    cumsum_wave(q.logf, q.ct); });
            else PHASE({ pg8::Sched<false> S{}; S.j0 = pg8::Job{q.hb, q.bin + (size_t)2048 * D, MP / 256, 8, 2, 0}; S.nj = 1; S.K = D; S.G = G; S.c = bx; S.ld = S.K;
                    pg8::EpiStore E{q.kb, q.vt, qg, D, 2048, 0.125f * LOG2E}; pg8::gemm_phase<pg8::EpiStore, false>(lds, S, E); });
#endif
#if defined(ATTN_NOLDS)
            PHASE(attn_phase2(q, qg, yb, smem, (unsigned*)(p.ws + W_CTL) + 16 + 16 * j));
#elif FAST_ATTN
            PHASE(attn_phase(q, qg, yb, smem, (unsigned*)(p.ws + W_CTL) + 16 + 16 * j));
#if defined(PROBE_DUP) || defined(PROBE_DUP_ATTN)
            PHASE(attn_phase(q, qg, yb, smem, (unsigned*)(p.ws + W_CTL) + 24 + 16 * j));
#endif
#if defined(PROBE_ATTN_SKEL)
            PHASE(attn_phase(q, qg, yb, smem, (unsigned*)(p.ws + W_CTL) + 24 + 16 * j, true));
#endif
#else
            PHASE(attn_simple(qg, q.kb, q.vt, q.ct, yb));
#endif
            PHASE({ pg8::Sched<false> S{}; S.j0 = pg8::Job{yb, q.bout + (size_t)j * D * D, 64, D / 256, 0, 0}; S.j1 = pg8::Job{yb + (size_t)TAIL0 * D, q.bout + (size_t)j * D * D, D / 256, D / 256, 2, 256};
                    S.nj = 2; S.K = D; S.G = G; S.c = bx; S.ld = D;
                    pg8::EpiStore E{mixm, nullptr, q.part, D, D}; pg8::gemm_phase<pg8::EpiStore, false>(lds, S, E); });
        }
        PHASE(ln_phase(p, q, q.hb, layer == 3 ? q.kb : (bf16_t*)nullptr, mixm, layer < 2 ? DR / 256 : D / 256, p.ln1_g + (size_t)layer * D, p.ln1_b + (size_t)layer * D, 0));
        PHASE({ pg8::Sched<true> S{}; S.j0 = pg8::Job{q.hb, q.fin + (size_t)layer * 5632 * D, 66, 22, 0, 0}; S.nj = 1; S.K = D; S.G = G; S.c = bx; S.ld = S.K;
                pg8::EpiFfn1 E{g, p.f_conv_w + (size_t)layer * 3 * 5632, p.f_conv_b + (size_t)layer * 5632, (LAS float*)(lds + pg8::STAGE_BYTES)}; pg8::gemm_phase<pg8::EpiFfn1, true>(lds, S, E); });
#if defined(PROBE_DUP2) || defined(PROBE_F1)
        PHASE({ pg8::Sched<true> S{}; S.j0 = pg8::Job{q.hb, q.fin + (size_t)layer * 5632 * D, 66, 22, 0, 0}; S.nj = 1; S.K = D; S.G = G; S.c = bx; S.ld = S.K;
                pg8::EpiFfn1 E{g, p.f_conv_w + (size_t)layer * 3 * 5632, p.f_conv_b + (size_t)layer * 5632, (LAS float*)(lds + pg8::STAGE_BYTES)}; pg8::gemm_phase<pg8::EpiFfn1, true>(lds, S, E); });
#endif
        PHASE({ pg8::Sched<false> S{}; S.j0 = pg8::Job{g, q.wfout + (size_t)layer * D * DFF, 64, D / 256, 0, 0}; S.j1 = pg8::Job{g + (size_t)TAIL0 * DFF, q.wfout + (size_t)layer * D * DFF, DFF / 256, D / 256, 2, 256};
                S.nj = 2; S.K = DFF; S.G = G; S.c = bx; S.ld = DFF;
                pg8::EpiStore E{mixf, nullptr, q.part, D, D}; pg8::gemm_phase<pg8::EpiStore, false>(lds, S, E); });
        PHASE(ln_phase(p, q, layer == 3 ? (const bf16_t*)q.kb : (const bf16_t*)q.hb, (bf16_t*)nullptr, mixf, DFF / 256, p.ln2_g + (size_t)layer * D, p.ln2_b + (size_t)layer * D, layer == 3 ? 2 : (layer == 1 ? 1 : 0)));
    }
#undef PHASE
}

extern "C" void kernel_launch(void* const* d_in, const int* in_sizes, int n_in, void* d_out, int out_size, void* d_ws, size_t ws_size, hipStream_t stream) {
    static int grid = 0;
    if (grid == 0) {
        int dev = 0, cus = 0, per_cu = 0;
        hipGetDevice(&dev); hipDeviceGetAttribute(&cus, hipDeviceAttributeMultiprocessorCount, dev);
        hipFuncSetAttribute((const void*)mega, hipFuncAttributeMaxDynamicSharedMemorySize, LDS_BYTES);
        hipOccupancyMaxActiveBlocksPerMultiprocessor(&per_cu, (const void*)mega, 512, LDS_BYTES);
        if (per_cu < 1) { fprintf(stderr, "kernel_launch: occupancy query says %d blocks/CU\n", per_cu); per_cu = 1; }
        grid = cus * per_cu;
        if (ws_size < W_END) fprintf(stderr, "kernel_launch: ws_size %zu < %zu\n", ws_size, (size_t)W_END);
    }
    hipMemsetAsync((unsigned char*)d_ws + W_CTL, 0, 4096, stream);
    Params p{};
    const float** f = (const float**)&p.x;
    for (int i = 0; i < 23; ++i) f[i] = (const float*)d_in[i];
    p.out = (float*)d_out; p.ws = (unsigned char*)d_ws; p.ph_lo = 0; p.ph_hi = 1000;
    void* args[] = {&p};
    hipError_t e = hipLaunchCooperativeKernel((const void*)mega, dim3(grid), dim3(512), args, LDS_BYTES, stream);
    if (e != hipSuccess) fprintf(stderr, "cooperative launch failed: %s (grid %d)\n", hipGetErrorString(e), grid);
}
```
